# Optimizing an MI355X kernel written in HIP

```python
import math
import numpy as np
import jax
import jax.numpy as jnp
from jax import lax

D_MODEL = 1024
BATCH = 8
SEQ = 2048
DEPTH = 4

MEM_LEN = 256
MIX_W = D_MODEL // 2
NSA_DH = 64
NSA_HEADS = MIX_W // NSA_DH
NSA_KV = 2
NSA_R = NSA_HEADS // NSA_KV
NSA_ROT = NSA_DH // 4
CMP_L = 32
CMP_D = 16
CMP_HID = 256
SEL_L = 64
N_SEL = 8
WINDOW = 256
QB = 128
HB = 4
HK = 128
HV = MIX_W // HB
HGRN_CHUNK = 64
HC = 8
NOPE = 64
ROPE_D = 32
VD = MIX_W // HC
Q_RANK = 384
KV_RANK = 256
XA_HEADS = 4
XA_DH = D_MODEL // XA_HEADS
D_FF = 256 * ((8 * D_MODEL // 3 + 255) // 256)
ROPE_THETA = 500000.0
LN_EPS = 1e-5
RMS_EPS = 1e-6
NEG = -1e30
BIG = 1e9
F_MIN = 1e-20
F32 = jnp.float32

IN_SIZES = (
    NSA_HEADS * NSA_DH,
    NSA_KV * NSA_DH, NSA_KV * NSA_DH,
    NSA_KV * NSA_DH, NSA_KV * NSA_DH,
    NSA_KV * NSA_DH, NSA_KV * NSA_DH,
    NSA_HEADS * 3,
    HB * HK, HB * HK,
    HB * HV, HB * HV,
    Q_RANK, KV_RANK, ROPE_D,
    3 * D_MODEL,
)
N_IN = sum(IN_SIZES)

kernel_name = 'hybrid_nsa_hgrn2_mla_deepnorm_macaron'


def layer_norm(x, g, b):
    xf = x.astype(F32)
    mu = jnp.mean(xf, -1, keepdims=True)
    var = jnp.mean(jnp.square(xf - mu), -1, keepdims=True)
    return ((xf - mu) * lax.rsqrt(var + LN_EPS) * g + b).astype(x.dtype)


def rms_norm(x, g):
    xf = x.astype(F32)
    return (xf * lax.rsqrt(jnp.mean(jnp.square(xf), -1, keepdims=True) + RMS_EPS) * g).astype(x.dtype)


def rope(x, pos, rot_dim):
    half = rot_dim // 2
    inv = ROPE_THETA ** (-jnp.arange(half, dtype=F32) / half)
    ang = pos.astype(F32)[..., None] * inv
    cos = jnp.cos(ang)[:, :, None, :]
    sin = jnp.sin(ang)[:, :, None, :]
    xr = x[..., :rot_dim].astype(F32)
    x1, x2 = xr[..., :half], xr[..., half:]
    rot = jnp.concatenate([x1 * cos - x2 * sin, x2 * cos + x1 * sin], -1).astype(x.dtype)
    return jnp.concatenate([rot, x[..., rot_dim:]], -1)


def masked_softmax(s, mask, axis=-1):
    p = jax.nn.softmax(jnp.where(mask, s, NEG), axis=axis)
    return jnp.where(mask, p, 0.0)


def swiglu(h, w1, w3, w2):
    return (jax.nn.silu(h @ w1) * (h @ w3)) @ w2


def nsa_mixer(q, kc, vc, ks, vs, kw, vw, gates, pos, cmp_pos, cmp_w1, cmp_w2):
    B, S = q.shape[:2]
    G, R, dh = NSA_KV, NSA_R, NSA_DH
    dt = q.dtype
    scale = dh ** -0.5
    t = jnp.arange(S)
    nq = S // QB
    qg = q.reshape(B, S, G, R, dh)
    qr = rope(q, pos, NSA_ROT).reshape(B, S, G, R, dh)
    ks = rope(ks, pos, NSA_ROT)
    kw = rope(kw, pos, NSA_ROT)

    n_cmp = (S - CMP_L) // CMP_D + 1
    start = np.arange(n_cmp) * CMP_D
    blk_idx = start[:, None] + np.arange(CMP_L)[None, :]

    def compress(z, pe, w1, w2):
        blocks = z[:, blk_idx] + pe[None, None, :, None, :]
        flat = blocks.transpose(0, 1, 3, 2, 4).reshape(B, n_cmp, G, CMP_L * dh)
        return jax.nn.gelu(flat @ w1) @ w2

    k_cmp = compress(kc, cmp_pos[0], cmp_w1[0], cmp_w2[0])
    v_cmp = compress(vc, cmp_pos[1], cmp_w1[1], cmp_w2[1])
    s_cmp = jnp.einsum('bsgrd,bngd->bgrsn', qg, k_cmp).astype(F32) * scale
    cmask = jnp.asarray(start + CMP_L - 1)[None, :] <= t[:, None]
    p_cmp = masked_softmax(s_cmp, cmask)
    o_cmp = jnp.einsum('bgrsn,bngd->bsgrd', p_cmp.astype(dt), v_cmp)

    n_slc = S // SEL_L
    j_np = np.arange(n_slc)
    overlap = np.clip(np.minimum(start[:, None] + CMP_L, (j_np[None, :] + 1) * SEL_L)
                      - np.maximum(start[:, None], j_np[None, :] * SEL_L), 0, None) / CMP_L
    imp = jnp.einsum('bgsn,nj->bgsj', p_cmp.sum(2), jnp.asarray(overlap, dtype=F32))
    j = jnp.arange(n_slc)
    cur = (t // SEL_L)[:, None]
    blk_valid = j[None, :] * SEL_L <= t[:, None]
    forced = (j[None, :] == 0) | (j[None, :] == cur) | (j[None, :] == cur - 1)
    score = jnp.where(blk_valid & forced, BIG, jnp.where(blk_valid, imp, -BIG))
    k_top = min(N_SEL, n_slc)
    top_val, top_idx = lax.top_k(score, k_top)
    top_ok = top_val > -0.5 * BIG

    k_blk = ks.reshape(B, n_slc, SEL_L, G, dh).transpose(0, 3, 1, 2, 4)
    v_blk = vs.reshape(B, n_slc, SEL_L, G, dh).transpose(0, 3, 1, 2, 4)
    bi = jnp.arange(B)[:, None, None, None]
    gi = jnp.arange(G)[None, :, None, None]
    q_ch = qr.reshape(B, nq, QB, G, R, dh).transpose(1, 0, 3, 2, 4, 5)
    idx_ch = top_idx.reshape(B, G, nq, QB, k_top).transpose(2, 0, 1, 3, 4)
    ok_ch = top_ok.reshape(B, G, nq, QB, k_top).transpose(2, 0, 1, 3, 4)
    t_ch = t.reshape(nq, QB)

    def sel_block(args):
        qc, ic, okc, tc = args
        kg = k_blk[bi, gi, ic]
        vg = v_blk[bi, gi, ic]
        s = jnp.einsum('bgtrd,bgtkld->bgtrkl', qc, kg).astype(F32) * scale
        kpos = ic[..., None] * SEL_L + jnp.arange(SEL_L)
        m = (kpos <= tc[None, None, :, None, None]) & okc[..., None]
        m = m[:, :, :, None].reshape(B, G, QB, 1, k_top * SEL_L)
        p = masked_softmax(s.reshape(B, G, QB, R, k_top * SEL_L), m).reshape(s.shape)
        return jnp.einsum('bgtrkl,bgtkld->bgtrd', p.astype(dt), vg)

    o_sel = lax.map(sel_block, (q_ch, idx_ch, ok_ch, t_ch))
    o_sel = o_sel.transpose(1, 0, 3, 2, 4, 5).reshape(B, S, G, R, dh)

    nwb = WINDOW // QB

    def band(z):
        zb = jnp.pad(z.reshape(B, nq, QB, G, dh), ((0, 0), (nwb, 0), (0, 0), (0, 0), (0, 0)))
        return jnp.concatenate([zb[:, o:o + nq] for o in range(nwb + 1)], axis=2)

    kwb, vwb = band(kw), band(vw)
    qpos = t.reshape(nq, QB)
    kpos = (jnp.arange(nq)[:, None] - nwb) * QB + jnp.arange((nwb + 1) * QB)[None, :]
    wmask = ((kpos[:, None, :] <= qpos[:, :, None]) & (kpos[:, None, :] > qpos[:, :, None] - WINDOW)
             & (kpos[:, None, :] >= 0))
    s_w = jnp.einsum('bnqgrd,bnkgd->bngrqk', qr.reshape(B, nq, QB, G, R, dh), kwb).astype(F32) * scale
    p_w = masked_softmax(s_w, wmask[None, :, None, None])
    o_win = jnp.einsum('bngrqk,bnkgd->bnqgrd', p_w.astype(dt), vwb).reshape(B, S, G, R, dh)

    gt = jax.nn.sigmoid(gates.astype(F32).reshape(B, S, G, R, 3)).astype(dt)
    o = gt[..., 0:1] * o_cmp + gt[..., 1:2] * o_sel + gt[..., 2:3] * o_win
    return o.reshape(B, S, G * R * dh)


def hgrn2_mixer(q, fz, i_in, g_out, lb, norm_g):
    B, S = q.shape[:2]
    H, dk, dv, C = HB, HK, HV, HGRN_CHUNK
    nc = S // C
    lb = lb.reshape(H, dk).astype(F32)
    zf = fz.reshape(B, S, H, dk).astype(F32)
    f = lb + (1.0 - lb) * jax.nn.sigmoid(zf)
    log_f = jnp.log(jnp.maximum(f, F_MIN))
    k = (1.0 - lb) * jax.nn.sigmoid(-zf)

    def chunks(z, d):
        return z.reshape(B, nc, C, H, d).transpose(1, 0, 3, 2, 4)

    qc = chunks(q.reshape(B, S, H, dk).astype(F32), dk)
    kc = chunks(k, dk)
    vc = chunks(i_in.reshape(B, S, H, dv).astype(F32), dv)
    lfc = chunks(log_f, dk)
    causal = jnp.tril(jnp.ones((C, C), dtype=bool))

    def step(state, inp):
        qt, kt, vt, lf = inp
        b = jnp.cumsum(lf, axis=2)
        inter = jnp.einsum('bhtd,bhde->bhte', qt * jnp.exp(b), state)
        diff = b[:, :, :, None, :] - b[:, :, None, :, :]
        decay = jnp.exp(jnp.where(causal[:, :, None], diff, NEG))
        a = jnp.einsum('bhtd,bhtsd,bhsd->bhts', qt, decay, kt)
        intra = jnp.einsum('bhts,bhse->bhte', a, vt)
        b_last = b[:, :, -1:, :]
        new_state = (jnp.exp(b_last[:, :, 0, :, None]) * state
                     + jnp.einsum('bhsd,bhse->bhde', kt * jnp.exp(b_last - b), vt))
        return new_state, inter + intra

    state0 = jnp.zeros((B, H, dk, dv), F32)
    _, o = lax.scan(step, state0, (qc, kc, vc, lfc))
    o = o.transpose(1, 0, 3, 2, 4).reshape(B, S, H, dv)
    o = rms_norm(o, norm_g) * jax.nn.silu(g_out.reshape(B, S, H, dv).astype(F32))
    return o.reshape(B, S, H * dv).astype(q.dtype)


def mla_mixer(cq, ckv, kr, pos, qn_g, w_uq, kvn_g, w_ukv):
    B, S = cq.shape[:2]
    q = (rms_norm(cq, qn_g) @ w_uq).reshape(B, S, HC, NOPE + ROPE_D)
    q_nope = q[..., :NOPE]
    q_pe = rope(q[..., NOPE:], pos, ROPE_D)
    kv = (rms_norm(ckv, kvn_g) @ w_ukv).reshape(B, S, HC, NOPE + VD)
    k_nope, v = kv[..., :NOPE], kv[..., NOPE:]
    k_pe = rope(kr[:, :, None, :], pos, ROPE_D)[:, :, 0]
    scale = (NOPE + ROPE_D) ** -0.5
    nq = S // QB
    t = jnp.arange(S)
    qn_ch = q_nope.reshape(B, nq, QB, HC, NOPE).transpose(1, 0, 2, 3, 4)
    qp_ch = q_pe.reshape(B, nq, QB, HC, ROPE_D).transpose(1, 0, 2, 3, 4)

    def attn_block(args):
        qn, qp, tc = args
        s = (jnp.einsum('bqhd,bkhd->bhqk', qn, k_nope)
             + jnp.einsum('bqhr,bkr->bhqk', qp, k_pe)).astype(F32) * scale
        p = masked_softmax(s, t[None, :] <= tc[:, None])
        return jnp.einsum('bhqk,bkhd->bqhd', p.astype(v.dtype), v)

    o = lax.map(attn_block, (qn_ch, qp_ch, t.reshape(nq, QB)))
    return o.transpose(1, 0, 2, 3, 4).reshape(B, S, HC * VD)


def memory_cross_attention(h, mem, wq, wk, wv, wo):
    B, S = h.shape[:2]
    q = (h @ wq).reshape(B, S, XA_HEADS, XA_DH)
    k = (mem @ wk).reshape(B, -1, XA_HEADS, XA_DH)
    v = (mem @ wv).reshape(B, -1, XA_HEADS, XA_DH)
    s = jnp.einsum('bshd,bmhd->bhsm', q, k).astype(F32) * (XA_DH ** -0.5)
    p = jax.nn.softmax(s, axis=-1).astype(h.dtype)
    return jnp.einsum('bhsm,bmhd->bshd', p, v).reshape(B, S, D_MODEL) @ wo


def setup_inputs(seed: int = 0) -> dict:
    key = jax.random.key(seed)
    ks = jax.random.split(key, 26)
    beta = (8.0 * DEPTH) ** -0.25

    def w(k, shape, fan_in, s=1.0):
        return jax.random.normal(k, shape, F32) * (s * fan_in ** -0.5)

    def gain(k, shape):
        return 1.0 + 0.02 * jax.random.normal(k, shape, F32)

    return {
        'x': jax.random.normal(ks[0], (BATCH, SEQ, D_MODEL), F32),
        'mem': jax.random.normal(ks[1], (BATCH, MEM_LEN, D_MODEL), F32),
        'positions': jnp.broadcast_to(jnp.arange(SEQ, dtype=jnp.int32), (BATCH, SEQ)),
        'ln_g': gain(ks[2], (DEPTH, 4, D_MODEL)),
        'ln_b': 0.02 * jax.random.normal(ks[3], (DEPTH, 4, D_MODEL), F32),
        'ffn_w1': w(ks[4], (DEPTH, 2, D_MODEL, D_FF), D_MODEL),
        'ffn_w3': w(ks[5], (DEPTH, 2, D_MODEL, D_FF), D_MODEL),
        'ffn_w2': w(ks[6], (DEPTH, 2, D_FF, D_MODEL), D_FF, beta),
        'w_in': w(ks[7], (DEPTH, D_MODEL, N_IN), D_MODEL),
        'nsa_cmp_pos': 0.1 * jax.random.normal(ks[8], (DEPTH, 2, CMP_L, NSA_DH), F32),
        'nsa_cmp_w1': w(ks[9], (DEPTH, 2, CMP_L * NSA_DH, CMP_HID), CMP_L * NSA_DH),
        'nsa_cmp_w2': w(ks[10], (DEPTH, 2, CMP_HID, NSA_DH), CMP_HID),
        'hgrn_lb_logits': 0.1 * jax.random.normal(ks[11], (DEPTH, HB * HK), F32),
        'hgrn_norm_g': gain(ks[12], (DEPTH, HV)),
        'mla_q_norm_g': gain(ks[13], (DEPTH, Q_RANK)),
        'mla_w_uq': w(ks[14], (DEPTH, Q_RANK, HC * (NOPE + ROPE_D)), Q_RANK),
        'mla_kv_norm_g': gain(ks[15], (DEPTH, KV_RANK)),
        'mla_w_ukv': w(ks[16], (DEPTH, KV_RANK, HC * (NOPE + VD)), KV_RANK),
        'w_branch': w(ks[17], (DEPTH, 3, MIX_W, D_MODEL), MIX_W, beta),
        'w_out': w(ks[18], (DEPTH, D_MODEL, D_MODEL), D_MODEL, beta),
        'xa_wq': w(ks[19], (DEPTH, D_MODEL, D_MODEL), D_MODEL),
        'xa_wk': w(ks[20], (DEPTH, D_MODEL, D_MODEL), D_MODEL),
        'xa_wv': w(ks[21], (DEPTH, D_MODEL, D_MODEL), D_MODEL),
        'xa_wo': w(ks[22], (DEPTH, D_MODEL, D_MODEL), D_MODEL, beta),
    }


def reference(x, mem, positions, ln_g, ln_b, ffn_w1, ffn_w3, ffn_w2, w_in, nsa_cmp_pos,
              nsa_cmp_w1, nsa_cmp_w2, hgrn_lb_logits, hgrn_norm_g, mla_q_norm_g, mla_w_uq,
              mla_kv_norm_g, mla_w_ukv, w_branch, w_out, xa_wq, xa_wk, xa_wv, xa_wo):
    B, S, _ = x.shape
    alpha = (2.0 * DEPTH) ** 0.25
    split_points = np.cumsum(IN_SIZES)[:-1].tolist()
    p_lb = jax.nn.softmax(hgrn_lb_logits.astype(F32), axis=0)
    lower_bounds = jnp.cumsum(p_lb, axis=0) - p_lb[0:1]
    for l in range(DEPTH):
        x = layer_norm(alpha * x + 0.5 * swiglu(x, ffn_w1[l, 0], ffn_w3[l, 0], ffn_w2[l, 0]),
                       ln_g[l, 0], ln_b[l, 0])
        (a_q, a_kc, a_vc, a_ks, a_vs, a_kw, a_vw, a_gate,
         b_q, b_f, b_i, b_g, c_q, c_kv, c_kr, merge) = jnp.split(x @ w_in[l], split_points, axis=-1)
        kvs = lambda z: z.reshape(B, S, NSA_KV, NSA_DH)
        y_a = nsa_mixer(a_q.reshape(B, S, NSA_HEADS, NSA_DH), kvs(a_kc), kvs(a_vc), kvs(a_ks),
                        kvs(a_vs), kvs(a_kw), kvs(a_vw), a_gate, positions,
                        nsa_cmp_pos[l], nsa_cmp_w1[l], nsa_cmp_w2[l])
        y_b = hgrn2_mixer(b_q, b_f, b_i, b_g, lower_bounds[l], hgrn_norm_g[l])
        y_c = mla_mixer(c_q, c_kv, c_kr, positions, mla_q_norm_g[l], mla_w_uq[l],
                        mla_kv_norm_g[l], mla_w_ukv[l])
        gates = jax.nn.sigmoid(merge.astype(F32).reshape(B, S, 3, D_MODEL)).astype(x.dtype)
        mixed = (gates[:, :, 0] * (y_a @ w_branch[l, 0]) + gates[:, :, 1] * (y_b @ w_branch[l, 1])
                 + gates[:, :, 2] * (y_c @ w_branch[l, 2]))
        x = layer_norm(alpha * x + mixed @ w_out[l], ln_g[l, 1], ln_b[l, 1])
        x = layer_norm(alpha * x + memory_cross_attention(x, mem, xa_wq[l], xa_wk[l], xa_wv[l], xa_wo[l]),
                       ln_g[l, 2], ln_b[l, 2])
        x = layer_norm(alpha * x + 0.5 * swiglu(x, ffn_w1[l, 1], ffn_w3[l, 1], ffn_w2[l, 1]),
                       ln_g[l, 3], ln_b[l, 3])
    return x
```

```cpp
#include <hip/hip_runtime.h>
#include <hip/hip_cooperative_groups.h>
#include <cstdio>
#include <cstdint>
namespace cg = cooperative_groups;

#define LAS __attribute__((address_space(3)))
typedef unsigned short bf16_t;
typedef short bf16x8 __attribute__((ext_vector_type(8)));
typedef float f32x4 __attribute__((ext_vector_type(4)));
typedef float f32x2 __attribute__((ext_vector_type(2)));
typedef unsigned u32x4 __attribute__((ext_vector_type(4)));
typedef unsigned u32x2 __attribute__((ext_vector_type(2)));

constexpr int T = 16384, DM = 1024, SEQ = 2048, DFF = 2816, NLAYER = 4, PLD = 6656;
constexpr float ALPHA = 1.6817928305074292f, LOG2E = 1.4426950408889634f;
constexpr int PC_Q = 0, PC_KS = 512, PC_KW = 640, PC_GATE = 768, PC_CQ = 800, PC_CKV = 1184, PC_KR = 1440, PC_BQ = 1472, PC_BF = 1984, PC_BI = 2496, PC_BG = 3008, PC_MG = 3520;
constexpr size_t MiB = 1048576;
constexpr size_t WS_LB = 0, WS_CBIAS = 8192, WS_RSQ = 65536, WS_RSKV = 131072, WS_DEC = 262144, WS_KCMP = 1 * MiB, WS_VCMPT = 1 * MiB + 262144;
constexpr size_t WS_CNT = 819200 + 16384;
constexpr size_t WS_BAR = 819200;
constexpr size_t WS_ROPEM = 2 * MiB, WS_ROPEN = 4 * MiB, WS_W = 5 * MiB, WS_XB = 69 * MiB, WS_Z = 101 * MiB, WS_S = 165 * MiB;
constexpr size_t WS_H = WS_S, WS_PROJ = WS_S, WS_KCG = WS_S + 208 * MiB, WS_VTN = WS_S + 217 * MiB, WS_HID = WS_S + 225 * MiB, WS_MQ = WS_S + 227 * MiB;
constexpr size_t WS_KNOPE = WS_S + 251 * MiB, WS_VTM = WS_S + 267 * MiB, WS_KPE = WS_S + 283 * MiB, WS_YA = WS_S + 284 * MiB, WS_YB = WS_S + 300 * MiB, WS_YC = WS_S + 316 * MiB;
constexpr size_t WS_XAK = WS_S + 332 * MiB, WS_XAVT = WS_S + 336 * MiB, WS_MEMB = WS_S + 340 * MiB, WS_KFN = WS_S + 344 * MiB, WS_XBUF = WS_S + 352 * MiB, WS_END = WS_S + 354 * MiB;
constexpr size_t WS_XQ = WS_S, WS_XP = WS_S + 32 * MiB, WS_XO = WS_S + 64 * MiB;
constexpr int W_UP1 = 0, W_DN1 = W_UP1 + 5632 * 1024, W_UP2 = W_DN1 + 1024 * 2816, W_DN2 = W_UP2 + 5632 * 1024, W_IN = W_DN2 + 1024 * 2816;
constexpr int W_CMP = W_IN + 7168 * 1024, W_UQ = W_CMP + 2 * 256 * 2048, W_KN = W_UQ + 768 * 384, W_VM = W_KN + 512 * 256, W_BR = W_VM + 512 * 256;
constexpr int W_OUT = W_BR + 3 * 1024 * 512, W_XQ = W_OUT + 1048576, W_XO = W_XQ + 1048576, W_XK = W_XO + 1048576, W_XV = W_XK + 1048576, W_ENDE = W_XV + 1048576;
static_assert((size_t)W_ENDE * 2 <= 64 * MiB, "weights region");
constexpr int LDS_BYTES = 155648;

__device__ __forceinline__ float bf2f(bf16_t v) { return __builtin_bit_cast(float, (unsigned)v << 16); }
__device__ __forceinline__ float bflo(unsigned w) { return __builtin_bit_cast(float, w << 16); }
__device__ __forceinline__ float bfhi(unsigned w) { return __builtin_bit_cast(float, w & 0xffff0000u); }
typedef __bf16 bf16x2_t __attribute__((ext_vector_type(2)));
__device__ __forceinline__ unsigned pk2(float lo, float hi) { const f32x2 v = {lo, hi}; const bf16x2_t b = __builtin_convertvector(v, bf16x2_t); return __builtin_bit_cast(unsigned, b); }
__device__ __forceinline__ float ex2(float x) { return __builtin_amdgcn_exp2f(x); }
__device__ __forceinline__ float rcpf(float x) { return __builtin_amdgcn_rcpf(x); }
__device__ __forceinline__ float sigm(float x) { return rcpf(1.f + ex2(-x * LOG2E)); }
__device__ __forceinline__ float wave_sum(float v) {
#pragma unroll
    for (int o = 1; o < 64; o <<= 1) v += __shfl_xor(v, o);
    return v;
}

__device__ __forceinline__ int tidx() { int t = threadIdx.x; asm volatile("" : "+v"(t)); return t; }
__device__ __forceinline__ int bidx() { int t = blockIdx.x; asm volatile("" : "+s"(t)); return t; }
__device__ __forceinline__ int gdim() { int t = gridDim.x; asm volatile("" : "+s"(t)); return t; }
__device__ __forceinline__ float rmax_fq(float x) { const unsigned u = __builtin_bit_cast(unsigned, x);
    auto r = __builtin_amdgcn_permlane16_swap(u, u, false, false); float y = fmaxf(__builtin_bit_cast(float, (unsigned)r[0]), __builtin_bit_cast(float, (unsigned)r[1]));
    const unsigned v = __builtin_bit_cast(unsigned, y); auto q = __builtin_amdgcn_permlane32_swap(v, v, false, false); return fmaxf(__builtin_bit_cast(float, (unsigned)q[0]), __builtin_bit_cast(float, (unsigned)q[1])); }
__device__ __forceinline__ float rsum_fq(float x) { const unsigned u = __builtin_bit_cast(unsigned, x);
    auto r = __builtin_amdgcn_permlane16_swap(u, u, false, false); float y = __builtin_bit_cast(float, (unsigned)r[0]) + __builtin_bit_cast(float, (unsigned)r[1]);
    const unsigned v = __builtin_bit_cast(unsigned, y); auto q = __builtin_amdgcn_permlane32_swap(v, v, false, false); return __builtin_bit_cast(float, (unsigned)q[0]) + __builtin_bit_cast(float, (unsigned)q[1]); }
__device__ __forceinline__ float rsum_quad(float x) { float y = x + __builtin_bit_cast(float, __builtin_amdgcn_update_dpp(0, __builtin_bit_cast(int, x), 0xB1, 0xF, 0xF, false));
    return y + __builtin_bit_cast(float, __builtin_amdgcn_update_dpp(0, __builtin_bit_cast(int, y), 0x4E, 0xF, 0xF, false)); }
__device__ __forceinline__ f32x4 mfma16(bf16x8 a, bf16x8 b, f32x4 c) { return __builtin_amdgcn_mfma_f32_16x16x32_bf16(a, b, c, 0, 0, 0); }
__device__ __forceinline__ bf16x8 ld8(const bf16_t* p) { return *(const bf16x8*)p; }
__device__ __forceinline__ int kfrag_off(int s, int d, int ndc) { const int kb32 = s >> 5, r = s & 31, u = (r >> 2) & 1, fr = (r >> 3) * 4 + (r & 3), dc = d >> 5, fq = (d >> 3) & 3, j = d & 7;
    return (((kb32 * 2 + u) * ndc + dc) * 64 + fq * 16 + fr) * 8 + j; }
__device__ __forceinline__ int vfrag_off(int s, int dv) { const int kb32 = s >> 5, fq = (s >> 3) & 3, j = s & 7, dt = dv >> 4, fr = dv & 15; return ((kb32 * 4 + dt) * 64 + fq * 16 + fr) * 8 + j; }

namespace g8 {
constexpr int BM = 256, BK = 64, HALF = 128, HTB = HALF * BK * 2, NXCD = 8, WGM = 8;
__device__ __forceinline__ int lds_byte(int r, int c) { const int st = (r >> 4) * 2 + (c >> 5), rr = r & 15, cc = c & 31, ob = rr * 64 + cc * 2; return st * 1024 + (ob ^ (((ob >> 9) & 1) << 5)); }
__device__ __forceinline__ void stage_rc(int b, int& R, int& C) { const int st = b / 1024, sb = b % 1024, swz = sb ^ (((sb >> 9) & 1) << 5); R = (st >> 1) * 16 + swz / 64; C = (st & 1) * 32 + (swz % 64) / 2; }
__device__ __forceinline__ int perm32(int rho) { const int n = rho >> 4, i = rho & 15; return 8 * (i >> 2) + 4 * n + (i & 3); }
struct Unit { int b, pm, pn; };
struct Desc { const bf16_t* A; const bf16_t* Bt; long aBS1, aBS2, bBS1, bBS2; int lda, ldb, K, nM, nN, nB, nB2, boff; long aN, bN, bB; };
__device__ __forceinline__ void desc_defaults(Desc& d) { d.aN = 0; d.bN = (long)BM * d.ldb; d.bB = 0; }
__device__ __forceinline__ bool get_unit(const Desc& d, int i, Unit& u) {
    const int G = gdim(); int c = bidx() - d.boff; if (c < 0) c += G;
    const long L = (long)i * G + c; const int per = d.nM * d.nN, nwg = per * d.nB; if (L >= nwg) return false;
    int wgid = (int)L; { const int q = nwg / NXCD, r = nwg % NXCD, xcd = wgid % NXCD, off = wgid / NXCD; wgid = (xcd < r ? xcd * (q + 1) : r * (q + 1) + (xcd - r) * q) + off; }
    u.b = wgid / per; const int w = wgid % per;
    const int nig = WGM * d.nN, gid = w / nig, fm = gid * WGM, gsz = (d.nM - fm) < WGM ? (d.nM - fm) : WGM;
    u.pm = fm + ((w % nig) % gsz); u.pn = (w % nig) / gsz; return true;
}
template <class Epi>
__device__ __forceinline__ void gemm_phase(LAS unsigned char* lds, const Desc& g, const Epi& E) {
    const int tid = tidx(), wid = __builtin_amdgcn_readfirstlane(tid >> 6), lane = tid & 63, wr = wid >> 2, wc = wid & 3, fr = lane & 15, fq = lane >> 4;
    const int K = g.K, nt = K / BK;
    unsigned voffA[2], voffB[2];
#pragma unroll
    for (int i = 0; i < 2; ++i) { int R, C; stage_rc(tid * 16 + i * 8192, R, C); const int Rb = (R & ~31) + perm32(R & 31);
        voffA[i] = (unsigned)(R * g.lda + C) * 2u; voffB[i] = (unsigned)(Rb * g.ldb + C) * 2u; }
    const size_t kstep = (size_t)(BK * 2);
    const size_t hstepA = (size_t)HALF * g.lda * 2, hstepB = (size_t)HALF * g.ldb * 2;
    const unsigned ldsw = (unsigned)wid * 1024u;
    const int aoff = lds_byte(wr * 64 + fr, fq * 8), boff = lds_byte(wc * 32 + fr, fq * 8);
#define G8_SA(b, h) (((b) * 2 + (h)) * HTB)
#define G8_SB(b, h) ((4 + (b) * 2 + (h)) * HTB)
#define G8_STAGE(bufoff, gbase, voff) do { _Pragma("unroll") for (int _i = 0; _i < 2; ++_i) \
        __builtin_amdgcn_global_load_lds((const unsigned*)((const char*)(gbase) + (voff)[_i]), (LAS unsigned*)(lds + (bufoff) + ldsw + _i * 8192), 16, 0, 0); } while (0)
#define G8_LDA(dst, b, h) do { _Pragma("unroll") for (int m = 0; m < 4; ++m) _Pragma("unroll") for (int k = 0; k < 2; ++k) dst[m][k] = *(const LAS bf16x8*)(lds + G8_SA(b, h) + aoff + m * 2048 + k * 1024); } while (0)
#define G8_LDB(dst, b, h) do { _Pragma("unroll") for (int n = 0; n < 2; ++n) _Pragma("unroll") for (int k = 0; k < 2; ++k) dst[n][k] = *(const LAS bf16x8*)(lds + G8_SB(b, h) + boff + n * 2048 + k * 1024); } while (0)
#define G8_MMA(ai, bj, At, Bt) do { __builtin_amdgcn_s_setprio(1); _Pragma("unroll") for (int m = 0; m < 4; ++m) _Pragma("unroll") for (int n = 0; n < 2; ++n) _Pragma("unroll") for (int k = 0; k < 2; ++k) \
        acc[ai][bj][m][n] = __builtin_amdgcn_mfma_f32_16x16x32_bf16(Bt[n][k], At[m][k], acc[ai][bj][m][n], 0, 0, 0); __builtin_amdgcn_s_setprio(0); } while (0)
#define G8_WAIT_V(n) asm volatile("s_waitcnt vmcnt(" #n ")" ::: "memory")
#define G8_WAIT_L(n) asm volatile("s_waitcnt lgkmcnt(" #n ")" ::: "memory")
#define G8_BAR __builtin_amdgcn_s_barrier()
#define G8_SCHED __builtin_amdgcn_sched_barrier(0)
#define G8_UA(u) ((const char*)g.A + 2 * ((size_t)((u).b / g.nB2) * g.aBS1 + (size_t)((u).b % g.nB2) * g.aBS2 + (size_t)(u).pm * BM * g.lda + (size_t)(u).pn * g.aN))
#define G8_UB(u) ((const char*)g.Bt + 2 * ((size_t)((u).b / g.nB2) * g.bBS1 + (size_t)((u).b % g.nB2) * g.bBS2 + (size_t)(u).pn * g.bN + (size_t)((u).pm >> 3) * g.bB))
    Unit cur, nxt; int ui = 0;
    if (!get_unit(g, 0, cur)) return;
    f32x4 acc[2][2][4][2];
#pragma unroll
    for (int a = 0; a < 2; ++a)
#pragma unroll
        for (int b = 0; b < 2; ++b)
#pragma unroll
            for (int m = 0; m < 4; ++m)
#pragma unroll
                for (int n = 0; n < 2; ++n) acc[a][b][m][n] = (f32x4){0.f, 0.f, 0.f, 0.f};
    bf16x8 At[4][2], B0[2][2], B1[2][2];
    const char* cA = G8_UA(cur); const char* cB = G8_UB(cur);
    G8_STAGE(G8_SB(0, 0), cB, voffB); G8_STAGE(G8_SB(0, 1), cB + hstepB, voffB); G8_STAGE(G8_SA(0, 0), cA, voffA); G8_STAGE(G8_SA(0, 1), cA + hstepA, voffA);
    if (wr == 1) G8_BAR;
    G8_WAIT_V(2); G8_BAR;
    G8_STAGE(G8_SB(1, 0), cB + kstep, voffB); G8_STAGE(G8_SA(1, 0), cA + kstep, voffA); G8_STAGE(G8_SB(1, 1), cB + hstepB + kstep, voffB);
    G8_WAIT_V(6); G8_BAR;
    for (;;) {
        const bool has_next = get_unit(g, ui + 1, nxt);
        const char* nA = has_next ? G8_UA(nxt) : cA; const char* nB = has_next ? G8_UB(nxt) : cB;
        for (int t = 0; t < nt; t += 2) {
            const bool last = (t == nt - 2);
            const char* a1 = cA + (size_t)(t + 1) * kstep;
            const char* a2 = last ? nA : cA + (size_t)(t + 2) * kstep; const char* b2 = last ? nB : cB + (size_t)(t + 2) * kstep;
            const char* a3 = a2 + kstep; const char* b3 = b2 + kstep;
            G8_LDB(B0, 0, 0); G8_LDB(B1, 0, 1); G8_SCHED; G8_LDA(At, 0, 0); G8_STAGE(G8_SA(1, 1), a1 + hstepA, voffA);
            G8_WAIT_V(8); G8_WAIT_L(0); G8_BAR; G8_MMA(0, 0, At, B0); G8_MMA(0, 1, At, B1); G8_BAR; G8_SCHED;
            G8_LDA(At, 0, 1); G8_STAGE(G8_SB(0, 0), b2, voffB); G8_STAGE(G8_SB(0, 1), b2 + hstepB, voffB); G8_STAGE(G8_SA(0, 0), a2, voffA);
            G8_WAIT_V(8); G8_WAIT_L(0); G8_BAR; G8_MMA(1, 0, At, B0); G8_MMA(1, 1, At, B1); G8_BAR; G8_SCHED;
            G8_LDB(B0, 1, 0); G8_LDB(B1, 1, 1); G8_SCHED; G8_LDA(At, 1, 0); G8_STAGE(G8_SA(0, 1), a2 + hstepA, voffA);
            G8_WAIT_V(8); G8_WAIT_L(0); G8_BAR; G8_MMA(0, 0, At, B0); G8_MMA(0, 1, At, B1); G8_BAR; G8_SCHED;
            G8_LDA(At, 1, 1); G8_STAGE(G8_SB(1, 0), b3, voffB); G8_STAGE(G8_SB(1, 1), b3 + hstepB, voffB); G8_STAGE(G8_SA(1, 0), a3, voffA);
            G8_WAIT_V(8); G8_WAIT_L(0); G8_BAR; G8_MMA(1, 0, At, B0); G8_MMA(1, 1, At, B1); G8_BAR; G8_SCHED;
        }
        if (wr == 0) G8_BAR;
        if constexpr (!Epi::AFTER_DRAIN) { E(acc, cur, wr, wc, fr, fq); }
        if (!has_next) break;
#pragma unroll
        for (int a = 0; a < 2; ++a)
#pragma unroll
            for (int b = 0; b < 2; ++b)
#pragma unroll
                for (int m = 0; m < 4; ++m)
#pragma unroll
                    for (int n = 0; n < 2; ++n) acc[a][b][m][n] = (f32x4){0.f, 0.f, 0.f, 0.f};
        cur = nxt; cA = nA; cB = nB; ++ui;
        if (wr == 1) G8_BAR;
    }
    G8_WAIT_V(0);
    G8_BAR;
    if constexpr (Epi::AFTER_DRAIN) { E.fused(acc, cur, wr, wc, fr, fq, lds, wid, lane); }
}

struct EpiSwiglu { static constexpr bool AFTER_DRAIN = false; bf16_t* H;
    __device__ __forceinline__ void operator()(const f32x4 (&acc)[2][2][4][2], const Unit& u, int wr, int wc, int fr, int fq) const {
        const int row0 = u.pm * BM + wr * 64 + fr, hc0 = u.pn * 128 + wc * 16 + fq * 4;
#pragma unroll
        for (int ai = 0; ai < 2; ++ai)
#pragma unroll
            for (int m = 0; m < 4; ++m) { bf16_t* rp = H + (size_t)(row0 + ai * HALF + m * 16) * DFF + hc0;
#pragma unroll
                for (int bj = 0; bj < 2; ++bj) { const f32x4 a = acc[ai][bj][m][0], b = acc[ai][bj][m][1]; float h[4];
#pragma unroll
                    for (int j = 0; j < 4; ++j) h[j] = a[j] * sigm(a[j]) * b[j];
                    u32x2 w; w.x = pk2(h[0], h[1]); w.y = pk2(h[2], h[3]); *(u32x2*)(rp + bj * 64) = w; } }
    }
};
struct EpiResid { static constexpr bool AFTER_DRAIN = false; const float* X; float* Z; float s;
    __device__ __forceinline__ void operator()(const f32x4 (&acc)[2][2][4][2], const Unit& u, int wr, int wc, int fr, int fq) const {
        const int row0 = u.pm * BM + wr * 64 + fr, c0 = u.pn * BM + wc * 32 + fq * 8;
#pragma unroll
        for (int ai = 0; ai < 2; ++ai)
#pragma unroll
            for (int m = 0; m < 4; ++m) { const size_t ro = (size_t)(row0 + ai * HALF + m * 16) * DM + c0;
#pragma unroll
                for (int bj = 0; bj < 2; ++bj)
#pragma unroll
                    for (int n = 0; n < 2; ++n) { const f32x4 x = *(const f32x4*)(X + ro + bj * HALF + n * 4); *(f32x4*)(Z + ro + bj * HALF + n * 4) = x * ALPHA + acc[ai][bj][m][n] * s; } }
    }
};
struct EpiLn { static constexpr bool AFTER_DRAIN = false; const float* XI; float* XF; bf16_t* XB; const float* g; const float* bt; float s; unsigned long long* xbuf; unsigned* cnt; unsigned target;
    __device__ __forceinline__ void operator()(f32x4 (&acc)[2][2][4][2], const Unit& u, int wr, int wc, int fr, int fq) const {
        const int row0 = u.pm * BM + wr * 64 + fr, c0 = u.pn * BM + wc * 32 + fq * 8;
        unsigned long long* xb0 = xbuf + ((size_t)u.pm * 256 + wr * 64 + fr) * 16;
#pragma unroll
        for (int ai = 0; ai < 2; ++ai)
#pragma unroll
            for (int m = 0; m < 4; ++m) { const size_t ro = (size_t)(row0 + ai * HALF + m * 16) * DM + c0; float s1 = 0.f, s2 = 0.f;
#pragma unroll
                for (int bj = 0; bj < 2; ++bj)
#pragma unroll
                    for (int n = 0; n < 2; ++n) { const f32x4 x = *(const f32x4*)(XI + ro + bj * HALF + n * 4); const f32x4 z = x * ALPHA + acc[ai][bj][m][n] * s; acc[ai][bj][m][n] = z;
                        s1 += (z[0] + z[1]) + (z[2] + z[3]); s2 += (z[0] * z[0] + z[1] * z[1]) + (z[2] * z[2] + z[3] * z[3]); }
                s1 = rsum_fq(s1); s2 = rsum_fq(s2);
                if (fq == 0) { const unsigned long long bits = ((unsigned long long)__builtin_bit_cast(unsigned, s2) << 32) | (unsigned long long)__builtin_bit_cast(unsigned, s1);
                    __hip_atomic_store(xb0 + (size_t)(ai * HALF + m * 16) * 16 + u.pn * 4 + wc, bits, __ATOMIC_RELAXED, __HIP_MEMORY_SCOPE_AGENT); }
                if (m == 3) __builtin_amdgcn_sched_barrier(0); }
        asm volatile("s_waitcnt vmcnt(0)" ::: "memory");
        unsigned* cw = cnt + (u.pm * 2 + wr) * 64;
        if (fr == 0 && fq == 0) (void)__hip_atomic_fetch_add(cw, 1u, __ATOMIC_RELAXED, __HIP_MEMORY_SCOPE_AGENT);
        for (unsigned sp = 0; sp < (1u << 22); ++sp) { if (__hip_atomic_load(cw, __ATOMIC_RELAXED, __HIP_MEMORY_SCOPE_AGENT) >= target) break; __builtin_amdgcn_s_sleep(2); }
        asm volatile("s_waitcnt vmcnt(0)" ::: "memory");
#pragma unroll
        for (int ai = 0; ai < 2; ++ai)
#pragma unroll
            for (int m = 0; m < 4; ++m) { const unsigned long long* rp = xb0 + (size_t)(ai * HALF + m * 16) * 16 + fq * 4; float s1 = 0.f, s2 = 0.f;
#pragma unroll
                for (int k = 0; k < 4; ++k) { const unsigned long long bits = __hip_atomic_load(rp + k, __ATOMIC_RELAXED, __HIP_MEMORY_SCOPE_AGENT);
                    s1 += __builtin_bit_cast(float, (unsigned)(bits & 0xffffffffull)); s2 += __builtin_bit_cast(float, (unsigned)(bits >> 32)); }
                s1 = rsum_fq(s1); s2 = rsum_fq(s2);
                const float mean = s1 * (1.f / 1024.f), rstd = rsqrtf(fmaxf(s2 * (1.f / 1024.f) - mean * mean, 0.f) + 1e-5f);
                const size_t ro = (size_t)(row0 + ai * HALF + m * 16) * DM + c0;
#pragma unroll
                for (int bj = 0; bj < 2; ++bj) { const int c = c0 + bj * HALF; const f32x4 g0 = *(const f32x4*)(g + c), g1 = *(const f32x4*)(g + c + 4), b0 = *(const f32x4*)(bt + c), b1 = *(const f32x4*)(bt + c + 4);
                    const f32x4 y0 = (acc[ai][bj][m][0] - mean) * rstd * g0 + b0, y1 = (acc[ai][bj][m][1] - mean) * rstd * g1 + b1;
                    *(f32x4*)(XF + ro + bj * HALF) = y0; *(f32x4*)(XF + ro + bj * HALF + 4) = y1;
                    u32x4 w; w.x = pk2(y0[0], y0[1]); w.y = pk2(y0[2], y0[3]); w.z = pk2(y1[0], y1[1]); w.w = pk2(y1[2], y1[3]); *(u32x4*)(XB + ro + bj * HALF) = w; }
                if (m == 3) __builtin_amdgcn_sched_barrier(0); }
    }
};
struct EpiStore { static constexpr bool AFTER_DRAIN = false;
    bf16_t* O; long oBS1, oBS2; int ldc, split_shift; long split_stride; const float* rowscale; const float* colscale; const float* bias; int act, nB2, lay;
    __device__ __forceinline__ void operator()(const f32x4 (&acc)[2][2][4][2], const Unit& u, int wr, int wc, int fr, int fq) const {
        bf16_t* base = O + (size_t)(u.b / nB2) * oBS1 + (size_t)(u.b % nB2) * oBS2;
        const int row0 = u.pm * BM + wr * 64 + fr, c0 = u.pn * BM + wc * 32 + fq * 8;
#pragma unroll
        for (int ai = 0; ai < 2; ++ai)
#pragma unroll
            for (int m = 0; m < 4; ++m) { const int row = row0 + ai * HALF + m * 16; const float rs = rowscale ? rowscale[row] : 1.f;
#pragma unroll
                for (int bj = 0; bj < 2; ++bj) { const int c = c0 + bj * HALF; float v[8];
#pragma unroll
                    for (int j = 0; j < 4; ++j) { v[j] = acc[ai][bj][m][0][j]; v[4 + j] = acc[ai][bj][m][1][j]; }
                    if (bias) {
#pragma unroll
                        for (int j = 0; j < 8; ++j) v[j] += bias[c + j]; }
                    if (act) {
#pragma unroll
                        for (int j = 0; j < 8; ++j) { const float x = v[j], uu = 0.7978845608028654f * (x + 0.044715f * x * x * x); v[j] = x * sigm(2.f * uu); } }
#ifdef MK_SAN3
                    if (act) {
#pragma unroll
                        for (int j = 0; j < 8; ++j) if (!(fabsf(v[j]) < 1.0e6f)) v[j] = 0.f; }
#endif
                    if (colscale) {
#pragma unroll
                        for (int j = 0; j < 8; ++j) v[j] *= colscale[c + j]; }
                    u32x4 w; w.x = pk2(v[0] * rs, v[1] * rs); w.y = pk2(v[2] * rs, v[3] * rs); w.z = pk2(v[4] * rs, v[5] * rs); w.w = pk2(v[6] * rs, v[7] * rs);
                    const size_t co = split_shift ? (size_t)(c >> split_shift) * split_stride + (c & ((1 << split_shift) - 1)) : (size_t)c;
                    bf16_t* dst = base + (size_t)row * ldc + co;
                    if (lay == 1) dst = base + (size_t)((row >> 6) * 8 + (c >> 11)) * 131072 + vfrag_off(c & 2047, row & 63);
                    else if (lay == 2) dst = base + (size_t)((c >> 6) * 8 + (row >> 11)) * 131072 + kfrag_off(row & 2047, c & 63, 2);
                    *(u32x4*)dst = w; } }
    }
};
struct EpiMerge { static constexpr bool AFTER_DRAIN = false; const bf16_t* P; float* Z; bf16_t* MX; int i;
    __device__ __forceinline__ void operator()(const f32x4 (&acc)[2][2][4][2], const Unit& u, int wr, int wc, int fr, int fq) const {
        const int row0 = u.pm * BM + wr * 64 + fr, c0 = u.pn * BM + wc * 32 + fq * 8;
#pragma unroll
        for (int ai = 0; ai < 2; ++ai)
#pragma unroll
            for (int m = 0; m < 4; ++m) { const int row = row0 + ai * HALF + m * 16;
#pragma unroll
                for (int bj = 0; bj < 2; ++bj) { const int c = c0 + bj * HALF;
                    const u32x4 gw = *(const u32x4*)(P + (size_t)row * PLD + PC_MG + i * DM + c);
                    float v[8];
                    v[0] = sigm(bflo(gw.x)) * acc[ai][bj][m][0][0]; v[1] = sigm(bfhi(gw.x)) * acc[ai][bj][m][0][1]; v[2] = sigm(bflo(gw.y)) * acc[ai][bj][m][0][2]; v[3] = sigm(bfhi(gw.y)) * acc[ai][bj][m][0][3];
                    v[4] = sigm(bflo(gw.z)) * acc[ai][bj][m][1][0]; v[5] = sigm(bfhi(gw.z)) * acc[ai][bj][m][1][1]; v[6] = sigm(bflo(gw.w)) * acc[ai][bj][m][1][2]; v[7] = sigm(bfhi(gw.w)) * acc[ai][bj][m][1][3];
#ifdef MK_BR
                    if (!((MK_BR >> i) & 1)) {
#pragma unroll
                        for (int j = 0; j < 8; ++j) v[j] = 0.f; }
#endif
                    bf16_t* mp = MX + (size_t)row * DM + c;
                    if (i > 0) { const u32x4 pv = *(const u32x4*)mp;
                        v[0] += bflo(pv.x); v[1] += bfhi(pv.x); v[2] += bflo(pv.y); v[3] += bfhi(pv.y); v[4] += bflo(pv.z); v[5] += bfhi(pv.z); v[6] += bflo(pv.w); v[7] += bfhi(pv.w); }
                    u32x4 w; w.x = pk2(v[0], v[1]); w.y = pk2(v[2], v[3]); w.z = pk2(v[4], v[5]); w.w = pk2(v[6], v[7]); *(u32x4*)mp = w; } }
    }
};
struct EpiMlaQ { static constexpr bool AFTER_DRAIN = false; bf16_t* O; const float* rstd; const f32x2* rope;
    __device__ __forceinline__ void operator()(const f32x4 (&acc)[2][2][4][2], const Unit& u, int wr, int wc, int fr, int fq) const {
        const int row0 = u.pm * BM + wr * 64 + fr, c0 = u.pn * BM + wc * 32 + fq * 8;
        const float qs = 0.10206207261596577f * LOG2E;
#pragma unroll
        for (int ai = 0; ai < 2; ++ai)
#pragma unroll
            for (int m = 0; m < 4; ++m) { const int row = row0 + ai * HALF + m * 16; const float rs = rstd[row];
#pragma unroll
                for (int bj = 0; bj < 2; ++bj) { const int c = c0 + bj * HALF; const bool pe = (((u.pn * BM + bj * HALF + wc * 32) >> 5) % 3) == 2;
                    float v[8];
#pragma unroll
                    for (int j = 0; j < 4; ++j) { v[j] = acc[ai][bj][m][0][j] * rs; v[4 + j] = acc[ai][bj][m][1][j] * rs; }
                    if (pe) {
#pragma unroll
                        for (int j = 0; j < 8; ++j) { const float o = __shfl_xor(v[j], 32); const f32x2 cs = rope[(size_t)row * 16 + ((fq & 1) * 8 + j)];
                            v[j] = (fq < 2) ? (v[j] * cs.x - o * cs.y) : (v[j] * cs.x + o * cs.y); } }
                    u32x4 w; w.x = pk2(v[0] * qs, v[1] * qs); w.y = pk2(v[2] * qs, v[3] * qs); w.z = pk2(v[4] * qs, v[5] * qs); w.w = pk2(v[6] * qs, v[7] * qs);
                    *(u32x4*)(O + (size_t)row * 768 + c) = w; } }
    }
};
struct EpiXaSoft { static constexpr bool AFTER_DRAIN = true; bf16_t* O; long oBS1, oBS2; int ldc, nB2; float sc;
    __device__ __forceinline__ void fused(const f32x4 (&acc)[2][2][4][2], const Unit& u, int wr, int wc, int fr, int fq, LAS unsigned char* lds, int wid, int lane) const {
        LAS float* red = (LAS float*)lds;
        LAS float* red2 = red + 1024;
#pragma unroll
        for (int ai = 0; ai < 2; ++ai)
#pragma unroll
            for (int m = 0; m < 4; ++m) { float v = -3.0e38f;
#pragma unroll
                for (int bj = 0; bj < 2; ++bj)
#pragma unroll
                    for (int n = 0; n < 2; ++n)
#pragma unroll
                        for (int j = 0; j < 4; ++j) v = fmaxf(v, acc[ai][bj][m][n][j]);
                v = rmax_fq(v);
                if (fq == 0) red[(ai * HALF + wr * 64 + m * 16 + fr) * 4 + wc] = v; }
        __syncthreads();
#pragma unroll
        for (int ai = 0; ai < 2; ++ai)
#pragma unroll
            for (int m = 0; m < 4; ++m) { const int rr = ai * HALF + wr * 64 + m * 16 + fr; const f32x4 q = *(const LAS f32x4*)(red + rr * 4);
                const float mm = fmaxf(fmaxf(q[0], q[1]), fmaxf(q[2], q[3])); float s = 0.f;
#pragma unroll
                for (int bj = 0; bj < 2; ++bj)
#pragma unroll
                    for (int n = 0; n < 2; ++n)
#pragma unroll
                        for (int j = 0; j < 4; ++j) s += ex2((acc[ai][bj][m][n][j] - mm) * sc);
                s = rsum_fq(s);
                if (fq == 0) red2[rr * 4 + wc] = s; }
        __syncthreads();
        bf16_t* base = O + (size_t)(u.b / nB2) * oBS1 + (size_t)(u.b % nB2) * oBS2;
#pragma unroll
        for (int ai = 0; ai < 2; ++ai)
#pragma unroll
            for (int m = 0; m < 4; ++m) { const int rr = ai * HALF + wr * 64 + m * 16 + fr; const f32x4 q = *(const LAS f32x4*)(red + rr * 4), q2 = *(const LAS f32x4*)(red2 + rr * 4);
                const float mm = fmaxf(fmaxf(q[0], q[1]), fmaxf(q[2], q[3])); const float inv = 1.f / ((q2[0] + q2[1]) + (q2[2] + q2[3]));
#pragma unroll
                for (int bj = 0; bj < 2; ++bj) { const int c = bj * HALF + wc * 32 + fq * 8; float p[8];
#pragma unroll
                    for (int j = 0; j < 4; ++j) { p[j] = ex2((acc[ai][bj][m][0][j] - mm) * sc) * inv; p[4 + j] = ex2((acc[ai][bj][m][1][j] - mm) * sc) * inv; }
                    u32x4 w; w.x = pk2(p[0], p[1]); w.y = pk2(p[2], p[3]); w.z = pk2(p[4], p[5]); w.w = pk2(p[6], p[7]);
                    *(u32x4*)(base + (size_t)(u.pm * BM + rr) * ldc + u.pn * BM + c) = w; } }
        asm volatile("s_waitcnt vmcnt(0)" ::: "memory");
        __syncthreads();
    }
};
}

struct FAS { f32x4 o[4]; float m, l; };
__device__ __forceinline__ void fas_init(FAS& s) {
#pragma unroll
    for (int d = 0; d < 4; ++d) s.o[d] = (f32x4){0.f, 0.f, 0.f, 0.f};
    s.m = -1.0e30f; s.l = 0.f;
}
template <int NDC> struct FAFrag { bf16x8 kf[2][NDC], vf[4]; };
template <int NDC>
__device__ __forceinline__ void fa_load(FAFrag<NDC>& f, const bf16_t* const (&kb)[NDC], const int (&kcs)[NDC], const bf16_t* vt, int key0, int lane) {
    const int kb32 = key0 >> 5;
#pragma unroll
    for (int u = 0; u < 2; ++u)
#pragma unroll
        for (int dc = 0; dc < NDC; ++dc) f.kf[u][dc] = ld8(kb[dc] + (size_t)(kb32 * 2 + u) * kcs[dc] + lane * 8);
#pragma unroll
    for (int dt = 0; dt < 4; ++dt) f.vf[dt] = ld8(vt + (size_t)(kb32 * 4 + dt) * 512 + lane * 8);
}
template <int NCT, int NDC, class MaskF>
__device__ __forceinline__ void fa_compute(FAS (&st)[NCT], const bf16x8 (&qf)[NCT][NDC], const FAFrag<NDC>& f, int key0, float sscale, bool domask, const MaskF& valid, int fr, int fq) {
#pragma unroll
    for (int ct = 0; ct < NCT; ++ct) {
        f32x4 s[2];
#pragma unroll
        for (int u = 0; u < 2; ++u) { s[u] = (f32x4){0.f, 0.f, 0.f, 0.f};
#pragma unroll
            for (int dc = 0; dc < NDC; ++dc) s[u] = mfma16(f.kf[u][dc], qf[ct][dc], s[u]); }
        float sv[8]; bool ok[8];
#pragma unroll
        for (int e = 0; e < 8; ++e) { sv[e] = s[e >> 2][e & 3] * sscale; ok[e] = domask ? valid(ct, key0 + fq * 8 + e) : true; }
        float mx = -1.0e30f;
#pragma unroll
        for (int e = 0; e < 8; ++e) mx = fmaxf(mx, ok[e] ? sv[e] : -1.0e30f);
        mx = rmax_fq(mx);
        const float mn = fmaxf(st[ct].m, mx), alpha = ex2(st[ct].m - mn);
        float p[8], ls = 0.f;
#pragma unroll
        for (int e = 0; e < 8; ++e) { p[e] = ok[e] ? ex2(sv[e] - mn) : 0.f; ls += p[e]; }
        ls = rsum_fq(ls);
        st[ct].l = st[ct].l * alpha + ls; st[ct].m = mn;
        u32x4 pw; pw.x = pk2(p[0], p[1]); pw.y = pk2(p[2], p[3]); pw.z = pk2(p[4], p[5]); pw.w = pk2(p[6], p[7]);
        const bf16x8 pb = __builtin_bit_cast(bf16x8, pw);
#pragma unroll
        for (int dt = 0; dt < 4; ++dt) { st[ct].o[dt] = st[ct].o[dt] * alpha; st[ct].o[dt] = mfma16(f.vf[dt], pb, st[ct].o[dt]); }
    }
}
template <int NCT, int NDC, class MaskF>
__device__ __forceinline__ void fa_step(FAS (&st)[NCT], const bf16x8 (&qf)[NCT][NDC], const bf16_t* const (&kb)[NDC], const int (&kcs)[NDC], const bf16_t* vt,
                                        int key0, float sscale, bool domask, const MaskF& valid, int lane) {
    FAFrag<NDC> f; fa_load<NDC>(f, kb, kcs, vt, key0, lane); fa_compute<NCT, NDC>(st, qf, f, key0, sscale, domask, valid, lane & 15, lane >> 4);
}
template <int NCT, int NDC, class MaskF>
__device__ __forceinline__ void fa_step2(FAS (&st)[NCT], const bf16x8 (&qf)[NCT][NDC], const bf16_t* const (&kb)[NDC], const int (&kcs)[NDC], const bf16_t* vt,
                                         int key0, float sscale, bool domask0, bool domask1, const MaskF& valid, int lane) {
    FAFrag<NDC> f0, f1; fa_load<NDC>(f0, kb, kcs, vt, key0, lane); fa_load<NDC>(f1, kb, kcs, vt, key0 + 32, lane);
    fa_compute<NCT, NDC>(st, qf, f0, key0, sscale, domask0, valid, lane & 15, lane >> 4); fa_compute<NCT, NDC>(st, qf, f1, key0 + 32, sscale, domask1, valid, lane & 15, lane >> 4);
}

#define XB_TMO      128
#define XB_XCNT(j)  (256  + 64 * (j))
#define XB_XSUB(j)  (1280 + 64 * (j))
#define XB_XGEN(j)  (2304 + 64 * (j))
#define XB_TOP      3328
#define XB_TOPGEN   3392
#define XCD_BAR_WORDS 3456
#define XB_SPIN_CAP (1u << 20)
__device__ __forceinline__ unsigned xb_ld(unsigned* p)              { return __hip_atomic_load(p, __ATOMIC_RELAXED, __HIP_MEMORY_SCOPE_AGENT); }
__device__ __forceinline__ unsigned xb_add(unsigned* p, unsigned v) { return __hip_atomic_fetch_add(p, v, __ATOMIC_RELAXED, __HIP_MEMORY_SCOPE_AGENT); }
__device__ __forceinline__ unsigned xb_xcc_id() { return (unsigned)__builtin_amdgcn_s_getreg((3 << 11) | 20) & 0xFu; }
#define XB_SPIN(cond, bar) do { unsigned _sp = 0; while (cond) { __builtin_amdgcn_s_sleep(1); \
    if ((++_sp & 255u) == 0u) { if (xb_ld(&(bar)[XB_TMO])) break; if (_sp > XB_SPIN_CAP) { atomicAdd(&(bar)[XB_TMO], 1u); break; } } } } while (0)
__device__ __forceinline__ void xcd_barrier_complete(unsigned* bar, unsigned x, unsigned& nloc, unsigned& nx) {
    const unsigned G = gridDim.x;
    unsigned sum, cnt, mine, sp = 0u;
    for (;;) {
        sum = 0u; cnt = 0u; mine = 0u;
#pragma unroll
        for (unsigned j = 0; j < 16; ++j) { const unsigned c = xb_ld(&bar[XB_XCNT(j)]); sum += c; cnt += (c > 0u) ? 1u : 0u; mine = (j == x) ? c : mine; }
        if (sum == G) break;
        __builtin_amdgcn_s_sleep(1);
        if ((++sp & 255u) == 0u) { if (xb_ld(&bar[XB_TMO])) break; if (sp > XB_SPIN_CAP) { atomicAdd(&bar[XB_TMO], 1u); break; } }
    }
    nloc = mine > 0u ? mine : 1u; nx = cnt > 0u ? cnt : 1u;
}
__device__ __forceinline__ void xcd_barrier(unsigned* bar, volatile LAS unsigned* st) {
    asm volatile("s_waitcnt vmcnt(0)" ::: "memory");
    __syncthreads();
    if (threadIdx.x == 0) {
        const unsigned x = xb_xcc_id();
        __builtin_amdgcn_s_waitcnt(0);
        unsigned nloc = st[0], nx = st[1];
        if (nloc == 0u) { xcd_barrier_complete(bar, x, nloc, nx); st[0] = nloc; st[1] = nx; }
        const unsigned old = xb_add(&bar[XB_XSUB(x)], 1u);
        const unsigned gen = old / nloc;
        if (old + 1u == (gen + 1u) * nloc) {
            __builtin_amdgcn_fence(__ATOMIC_RELEASE, "agent");
            asm volatile("s_waitcnt vmcnt(0)" ::: "memory");
            const unsigned og = xb_add(&bar[XB_TOP], 1u);
            const unsigned tg = og / nx;
            if (og + 1u == (tg + 1u) * nx) xb_add(&bar[XB_TOPGEN], 1u);
            else XB_SPIN(xb_ld(&bar[XB_TOPGEN]) == tg, bar);
            __builtin_amdgcn_fence(__ATOMIC_ACQUIRE, "agent");
            xb_add(&bar[XB_XGEN(x)], 1u);
            asm volatile("s_waitcnt vmcnt(0)" ::: "memory");
        } else {
            XB_SPIN(xb_ld(&bar[XB_XGEN(x)]) == gen, bar);
            __builtin_amdgcn_fence(__ATOMIC_ACQUIRE, "agent");
            asm volatile("s_waitcnt vmcnt(0)" ::: "memory");
        }
    }
    __syncthreads();
}

struct Args { const void* in[24]; float* out; unsigned char* ws; int ph_lo, ph_hi; };
__device__ __forceinline__ unsigned char* wsp(const Args& a) { unsigned char* p = a.ws; asm volatile("" : "+s"(p)); return p; }
__device__ __forceinline__ const void* inp(const Args& a, int i) { const void* p = a.in[i]; asm volatile("" : "+s"(p)); return p; }
__device__ __forceinline__ float* outp(const Args& a) { float* p = a.out; asm volatile("" : "+s"(p)); return p; }

__device__ __forceinline__ void phase_init(const Args& a) {
    unsigned char* ws = wsp(a);
    const int gtid = bidx() * 512 + tidx(), GT = gdim() * 512;
    const int* pos = (const int*)inp(a, 2);
    f32x2* ropeM = (f32x2*)(ws + WS_ROPEM); f32x2* ropeN = (f32x2*)(ws + WS_ROPEN);
    for (int idx = gtid; idx < T * 16; idx += GT) { const int tok = idx >> 4, i = idx & 15; const float p = (float)pos[tok];
        { const float inv = powf(500000.0f, -(float)i / 16.0f), ang = p * inv; ropeM[idx] = (f32x2){cosf(ang), sinf(ang)}; }
        if (i < 8) { const float inv = powf(500000.0f, -(float)i / 8.0f), ang = p * inv; ropeN[tok * 8 + i] = (f32x2){cosf(ang), sinf(ang)}; } }
    if (gtid < 512) { const float* lg = (const float*)inp(a, 12); float* lb = (float*)(ws + WS_LB);
        const float l0 = lg[gtid], l1 = lg[512 + gtid], l2 = lg[1024 + gtid], l3 = lg[1536 + gtid], m = fmaxf(fmaxf(l0, l1), fmaxf(l2, l3));
        const float e0 = expf(l0 - m), e1 = expf(l1 - m), e2 = expf(l2 - m), e3 = expf(l3 - m), inv = 1.f / (e0 + e1 + e2 + e3);
        const float p0 = e0 * inv, p1 = e1 * inv, p2 = e2 * inv, p3 = e3 * inv; const float c1 = p0 + p1, c2 = c1 + p2, c3 = c2 + p3;
        lb[gtid] = 0.f; lb[512 + gtid] = c1 - p0; lb[1024 + gtid] = c2 - p0; lb[1536 + gtid] = c3 - p0; }
    { const f32x4* x = (const f32x4*)inp(a, 0); f32x4* xf = (f32x4*)outp(a); u32x2* xb = (u32x2*)(ws + WS_XB);
      for (int i = gtid; i < T * DM / 4; i += GT) { const f32x4 v = x[i]; u32x2 w; w.x = pk2(v[0], v[1]); w.y = pk2(v[2], v[3]); xb[i] = w; } (void)xf; }
    { const f32x4* x = (const f32x4*)inp(a, 1); u32x2* mb = (u32x2*)(ws + WS_MEMB);
      for (int i = gtid; i < 2048 * DM / 4; i += GT) { const f32x4 v = x[i]; u32x2 w; w.x = pk2(v[0], v[1]); w.y = pk2(v[2], v[3]); mb[i] = w; } }
    { unsigned* z = (unsigned*)(ws + WS_KCG + 8 * MiB); for (int i = gtid; i < 16384; i += GT) z[i] = 0u; }
    if (bidx() == 0) { unsigned* bz = (unsigned*)(ws + WS_BAR); for (int i = tidx(); i < 12288 + 256; i += 512) bz[i] = 0u; }
}

constexpr int NSEG = 36;
__device__ const int SEGT[NSEG][10] = {
    {5, 2 * 1024 * 2816, 0, 2816, 0, 2816, 1024, W_UP1, 1, -1}, {6, 2 * 1024 * 2816, 0, 2816, 0, 2816, 1024, W_UP1, 2, -1},
    {5, 2 * 1024 * 2816, 1024 * 2816, 2816, 0, 2816, 1024, W_UP2, 1, -1}, {6, 2 * 1024 * 2816, 1024 * 2816, 2816, 0, 2816, 1024, W_UP2, 2, -1},
    {7, 2 * 2816 * 1024, 0, 1024, 0, 1024, 2816, W_DN1, 0, -1}, {7, 2 * 2816 * 1024, 2816 * 1024, 1024, 0, 1024, 2816, W_DN2, 0, -1},
    {8, 1024 * 7096, 0, 7096, 0, 512, 1024, W_IN + 0 * 1024, 0, -1},
    {8, 1024 * 7096, 0, 7096, 512, 128, 1024, W_IN + 6656 * 1024, 0, -1},
    {8, 1024 * 7096, 0, 7096, 640, 128, 1024, W_IN + 6784 * 1024, 0, -1},
    {8, 1024 * 7096, 0, 7096, 768, 128, 1024, W_IN + 512 * 1024, 0, -1},
    {8, 1024 * 7096, 0, 7096, 896, 128, 1024, W_IN + 6912 * 1024, 0, -1},
    {8, 1024 * 7096, 0, 7096, 1024, 128, 1024, W_IN + 640 * 1024, 0, -1},
    {8, 1024 * 7096, 0, 7096, 1152, 128, 1024, W_IN + 7040 * 1024, 0, -1},
    {8, 1024 * 7096, 0, 7096, 1280, 24, 1024, W_IN + 768 * 1024, 0, -1},
    {8, 1024 * 7096, 0, 7096, 1304, 512, 1024, W_IN + 1472 * 1024, 0, -1},
    {8, 1024 * 7096, 0, 7096, 1816, 512, 1024, W_IN + 1984 * 1024, 0, -1},
    {8, 1024 * 7096, 0, 7096, 2328, 512, 1024, W_IN + 2496 * 1024, 0, -1},
    {8, 1024 * 7096, 0, 7096, 2840, 512, 1024, W_IN + 3008 * 1024, 0, -1},
    {8, 1024 * 7096, 0, 7096, 3352, 384, 1024, W_IN + 800 * 1024, 0, -1},
    {8, 1024 * 7096, 0, 7096, 3736, 256, 1024, W_IN + 1184 * 1024, 0, -1},
    {8, 1024 * 7096, 0, 7096, 3992, 32, 1024, W_IN + 1440 * 1024, 0, -1},
    {8, 1024 * 7096, 0, 7096, 4024, 3072, 1024, W_IN + 3520 * 1024, 0, -1},
    {0, 0, 0, 0, 0, 8, 1024, W_IN + 792 * 1024, 3, -1}, {0, 0, 0, 0, 0, 64, 1024, W_IN + 6592 * 1024, 3, -1},
    {10, 2 * 2048 * 256, 0, 256, 0, 256, 2048, W_CMP, 0, -1}, {10, 2 * 2048 * 256, 2048 * 256, 256, 0, 256, 2048, W_CMP + 256 * 2048, 0, -1},
    {15, 384 * 768, 0, 768, 0, 768, 384, W_UQ, 0, 14},
    {17, 256 * 1024, 0, 1024, 0, 1024, 256, W_KN, 4, 16},
    {18, 3 * 512 * 1024, 0, 1024, 0, 1024, 512, W_BR, 0, -1}, {18, 3 * 512 * 1024, 512 * 1024, 1024, 0, 1024, 512, W_BR + 1024 * 512, 0, -1}, {18, 3 * 512 * 1024, 2 * 512 * 1024, 1024, 0, 1024, 512, W_BR + 2 * 1024 * 512, 0, -1},
    {19, 1048576, 0, 1024, 0, 1024, 1024, W_OUT, 0, -1}, {20, 1048576, 0, 1024, 0, 1024, 1024, W_XQ, 0, -1}, {23, 1048576, 0, 1024, 0, 1024, 1024, W_XO, 0, -1},
    {21, 1048576, 0, 1024, 0, 1024, 1024, W_XK, 0, -1}, {22, 1048576, 0, 1024, 0, 1024, 1024, W_XV, 0, -1},
};
__device__ __forceinline__ void phase_conv(const Args& a, int l, LAS unsigned char* lds) {
    LAS float* tile = (LAS float*)lds;
    bf16_t* W = (bf16_t*)(wsp(a) + WS_W);
    const int tid = tidx(), G = gdim();
    int rot = 0;
    for (int s = 0; s < NSEG; ++s) {
        const int src = SEGT[s][0], lstr = SEGT[s][1], extra = SEGT[s][2], ld = SEGT[s][3], col0 = SEGT[s][4], ncols = SEGT[s][5], K = SEGT[s][6], dsto = SEGT[s][7], mode = SEGT[s][8], ksrc = SEGT[s][9];
        const int ntn = (ncols + 127) >> 7, ntk = K >> 6, items = ntn * ntk;
        const float* S = (const float*)inp(a, src) + (size_t)l * lstr + extra;
        const float* KS = ksrc >= 0 ? (const float*)inp(a, ksrc) + (size_t)l * K : nullptr;
        bf16_t* D = W + dsto;
        int first = bidx() - rot; if (first < 0) first += G;
        const int kq = tid >> 5, n4 = (tid & 31) * 4;
        f32x4 pv[4]; float pks[4];
#pragma unroll
        for (int i = 0; i < 4; ++i) { pv[i] = (f32x4){0.f, 0.f, 0.f, 0.f}; pks[i] = 1.f; }
        if (first < items && mode != 3) { const int tn = first / ntk, tk = first % ntk, n0 = tn * 128, k0 = tk * 64;
#pragma unroll
            for (int i = 0; i < 4; ++i) { const int k = i * 16 + kq; if (n0 + n4 < ncols) { pv[i] = *(const f32x4*)(S + (size_t)(k0 + k) * ld + col0 + n0 + n4); if (KS) pks[i] = KS[k0 + k]; } } }
        for (int it = first; it < items; it += G) {
            const int tn = it / ntk, tk = it % ntk, n0 = tn * 128, k0 = tk * 64;
            if (mode != 3) {
#pragma unroll
                for (int i = 0; i < 4; ++i) { const int k = i * 16 + kq; const f32x4 v = pv[i] * pks[i];
                    tile[k * 129 + n4] = v[0]; tile[k * 129 + n4 + 1] = v[1]; tile[k * 129 + n4 + 2] = v[2]; tile[k * 129 + n4 + 3] = v[3]; }
            }
            __syncthreads();
            { const int nit = it + G;
              if (nit < items && mode != 3) { const int tn2 = nit / ntk, tk2 = nit % ntk, n02 = tn2 * 128, k02 = tk2 * 64;
#pragma unroll
                  for (int i = 0; i < 4; ++i) { const int k = i * 16 + kq; pv[i] = (f32x4){0.f, 0.f, 0.f, 0.f}; pks[i] = 1.f;
                      if (n02 + n4 < ncols) { pv[i] = *(const f32x4*)(S + (size_t)(k02 + k) * ld + col0 + n02 + n4); if (KS) pks[i] = KS[k02 + k]; } } } }
            { const int n = tid >> 2, kc = (tid & 3) * 16, nn = n0 + n;
              if (nn < ncols) {
                  int dr = nn;
                  if (mode == 1) dr = (nn >> 2) * 8 + (nn & 3); else if (mode == 2) dr = (nn >> 2) * 8 + 4 + (nn & 3); else if (mode == 4) dr = ((nn & 64) ? 512 : 0) + (nn >> 7) * 64 + (nn & 63);
                  u32x4 w0 = (u32x4){0u, 0u, 0u, 0u}, w1 = (u32x4){0u, 0u, 0u, 0u};
                  if (mode != 3) { const LAS float* tp = tile + kc * 129 + n;
                      w0.x = pk2(tp[0], tp[129]); w0.y = pk2(tp[2 * 129], tp[3 * 129]); w0.z = pk2(tp[4 * 129], tp[5 * 129]); w0.w = pk2(tp[6 * 129], tp[7 * 129]);
                      w1.x = pk2(tp[8 * 129], tp[9 * 129]); w1.y = pk2(tp[10 * 129], tp[11 * 129]); w1.z = pk2(tp[12 * 129], tp[13 * 129]); w1.w = pk2(tp[14 * 129], tp[15 * 129]); }
                  bf16_t* dp = D + (size_t)dr * K + k0 + kc; *(u32x4*)dp = w0; *(u32x4*)(dp + 8) = w1; } }
            __syncthreads();
        }
        rot = (rot + items) % G;
    }
}

__device__ __forceinline__ void phase_ln(const Args& a, int l, int j, bool do_bias) {
    const int lane = tidx() & 63, gw = bidx() * 8 + (tidx() >> 6), GW = gdim() * 8;
    const float* g = (const float*)inp(a, 3) + (size_t)(l * 4 + j) * DM; const float* bb = (const float*)inp(a, 4) + (size_t)(l * 4 + j) * DM;
    const float* Z = (const float*)(wsp(a) + WS_Z); float* XF = outp(a); bf16_t* XB = (bf16_t*)(wsp(a) + WS_XB);
    f32x4 gv[4], bv[4];
#pragma unroll
    for (int i = 0; i < 4; ++i) { gv[i] = *(const f32x4*)(g + i * 256 + lane * 4); bv[i] = *(const f32x4*)(bb + i * 256 + lane * 4); }
    for (int row = gw; row < T; row += GW) {
        f32x4 v[4]; float s = 0.f;
#pragma unroll
        for (int i = 0; i < 4; ++i) { v[i] = *(const f32x4*)(Z + (size_t)row * DM + i * 256 + lane * 4); s += (v[i][0] + v[i][1]) + (v[i][2] + v[i][3]); }
        const float mu = wave_sum(s) * (1.f / 1024.f); float q = 0.f;
#pragma unroll
        for (int i = 0; i < 4; ++i) { const f32x4 d = v[i] - mu; q += (d[0] * d[0] + d[1] * d[1]) + (d[2] * d[2] + d[3] * d[3]); }
        const float rstd = rsqrtf(wave_sum(q) * (1.f / 1024.f) + 1e-5f);
#pragma unroll
        for (int i = 0; i < 4; ++i) { const f32x4 o = (v[i] - mu) * rstd * gv[i] + bv[i]; *(f32x4*)(XF + (size_t)row * DM + i * 256 + lane * 4) = o;
            u32x2 w; w.x = pk2(o[0], o[1]); w.y = pk2(o[2], o[3]); *(u32x2*)(XB + (size_t)row * DM + i * 256 + lane * 4) = w; }
    }
    if (do_bias && gw < 512) {
        const int which = gw >> 8, n = gw & 255; const bf16_t* w = (const bf16_t*)(wsp(a) + WS_W) + W_CMP + (size_t)(which * 256 + n) * 2048;
        const float* pe = (const float*)inp(a, 9) + (size_t)(l * 2 + which) * 2048; float s = 0.f;
#pragma unroll
        for (int i = 0; i < 4; ++i) { const int k = i * 512 + lane * 8; const u32x4 ww = *(const u32x4*)(w + k); const f32x4 p0 = *(const f32x4*)(pe + k), p1 = *(const f32x4*)(pe + k + 4);
            s += bflo(ww.x) * p0[0] + bfhi(ww.x) * p0[1] + bflo(ww.y) * p0[2] + bfhi(ww.y) * p0[3] + bflo(ww.z) * p1[0] + bfhi(ww.z) * p1[1] + bflo(ww.w) * p1[2] + bfhi(ww.w) * p1[3]; }
        s = wave_sum(s); if (lane == 0) ((float*)(wsp(a) + WS_CBIAS))[gw] = s;
    }
}

__device__ __forceinline__ void s1_tokens(const Args& a) {
    const int lane = tidx() & 63, gw = bidx() * 8 + (tidx() >> 6), GW = gdim() * 8;
    bf16_t* P = (bf16_t*)(wsp(a) + WS_PROJ); const f32x2* ropeM = (const f32x2*)(wsp(a) + WS_ROPEM); const f32x2* ropeN = (const f32x2*)(wsp(a) + WS_ROPEN);
    bf16_t* kpe = (bf16_t*)(wsp(a) + WS_KPE); bf16_t* kfn = (bf16_t*)(wsp(a) + WS_KFN); float* rsq = (float*)(wsp(a) + WS_RSQ); float* rskv = (float*)(wsp(a) + WS_RSKV);
    for (int tok = gw; tok < T; tok += GW) {
        bf16_t* row = P + (size_t)tok * PLD;
        const int b = tok >> 11, sq = tok & 2047;
        { const int l5 = lane & 31, tg = l5 >> 3, ch = l5 & 7;
          u32x4 v = *(const u32x4*)(row + PC_KS + tg * 64 + ch * 8); u32x4 par;
          par.x = (unsigned)__shfl_xor((int)v.x, 1); par.y = (unsigned)__shfl_xor((int)v.y, 1); par.z = (unsigned)__shfl_xor((int)v.z, 1); par.w = (unsigned)__shfl_xor((int)v.w, 1);
          if (ch < 2) { const float sgn = (ch == 0) ? -1.f : 1.f; const unsigned ow[4] = {v.x, v.y, v.z, v.w}, pw[4] = {par.x, par.y, par.z, par.w}; unsigned rw[4];
#pragma unroll
              for (int j = 0; j < 4; ++j) { const f32x2 c0 = ropeN[tok * 8 + 2 * j], c1 = ropeN[tok * 8 + 2 * j + 1];
                  rw[j] = pk2(bflo(ow[j]) * c0.x + sgn * bflo(pw[j]) * c0.y, bfhi(ow[j]) * c1.x + sgn * bfhi(pw[j]) * c1.y); }
              v = (u32x4){rw[0], rw[1], rw[2], rw[3]}; }
          if (lane < 32) *(u32x4*)(kfn + (size_t)(((tg >> 1) * 8 + b) * 2 + (tg & 1)) * 131072 + kfrag_off(sq, ch * 8, 2)) = v; }
        if (lane >= 32 && lane < 48) { const int i = lane - 32; const float x1 = bf2f(row[PC_KR + i]), x2 = bf2f(row[PC_KR + 16 + i]); const f32x2 cs = ropeM[tok * 16 + i];
            const unsigned w = pk2(x1 * cs.x - x2 * cs.y, x2 * cs.x + x1 * cs.y); kpe[(size_t)b * 65536 + kfrag_off(sq, i, 1)] = (bf16_t)(w & 0xffffu); kpe[(size_t)b * 65536 + kfrag_off(sq, 16 + i, 1)] = (bf16_t)(w >> 16); }
        float s1 = 0.f, s2 = 0.f;
#pragma unroll
        for (int i = 0; i < 6; ++i) { const float v = bf2f(row[PC_CQ + i * 64 + lane]); s1 += v * v; }
#pragma unroll
        for (int i = 0; i < 4; ++i) { const float v = bf2f(row[PC_CKV + i * 64 + lane]); s2 += v * v; }
        s1 = wave_sum(s1); s2 = wave_sum(s2);
        if (lane == 0) { rsq[tok] = rsqrtf(s1 * (1.f / 384.f) + 1e-6f); rskv[tok] = rsqrtf(s2 * (1.f / 256.f) + 1e-6f); }
    }
}

__device__ __forceinline__ void hgrn_stage1(const Args& a, int l, int item, LAS unsigned char* lds) {
    constexpr int RS = 132, AS = 68, TS = 72;
    LAS float* q = (LAS float*)lds; LAS float* bb = q + 64 * RS; LAS float* kk = bb + 64 * RS; LAS float* Am = kk + 64 * RS; LAS float* X = Am + 64 * AS;
    LAS bf16_t* kT = (LAS bf16_t*)q;
    LAS bf16_t* vT = (LAS bf16_t*)X;
    LAS float* tot = X;
    const int tid = tidx(), lane = tid & 63, w = tid >> 6, fr = lane & 15, fq = lane >> 4; const int b = item >> 7, h = (item >> 5) & 3, c = item & 31; const int tok0 = b * SEQ + c * 64;
    bf16_t* P = (bf16_t*)(wsp(a) + WS_PROJ); const float* lbp = (const float*)(wsp(a) + WS_LB) + l * 512 + h * 128;
    for (int idx = tid; idx < 1024; idx += 512) { const int t = idx >> 4, d0 = (idx & 15) * 8; const bf16_t* row = P + (size_t)(tok0 + t) * PLD + h * 128 + d0;
        const u32x4 qw = *(const u32x4*)(row + PC_BQ), zw = *(const u32x4*)(row + PC_BF); const f32x4 l0 = *(const f32x4*)(lbp + d0), l1 = *(const f32x4*)(lbp + d0 + 4);
        const float qv[8] = {bflo(qw.x), bfhi(qw.x), bflo(qw.y), bfhi(qw.y), bflo(qw.z), bfhi(qw.z), bflo(qw.w), bfhi(qw.w)};
        const float zv[8] = {bflo(zw.x), bfhi(zw.x), bflo(zw.y), bfhi(zw.y), bflo(zw.z), bfhi(zw.z), bflo(zw.w), bfhi(zw.w)};
        const float lb[8] = {l0[0], l0[1], l0[2], l0[3], l1[0], l1[1], l1[2], l1[3]};
#pragma unroll
        for (int j = 0; j < 8; ++j) { const float en = ex2(-fminf(fmaxf(zv[j], -80.f), 80.f) * LOG2E), sg = rcpf(1.f + en), sgn = en * sg; const float f = lb[j] + (1.f - lb[j]) * sg;
            q[t * RS + d0 + j] = qv[j]; bb[t * RS + d0 + j] = __log2f(fmaxf(f, 1e-20f)); kk[t * RS + d0 + j] = (1.f - lb[j]) * sgn; } }
    __syncthreads();
    {
        const int d = tid & 127, p = tid >> 7; float vals[16]; float run = 0.f;
#pragma unroll
        for (int i = 0; i < 16; ++i) { run += bb[(16 * p + i) * RS + d]; vals[i] = run; }
        tot[p * 128 + d] = run;
        __syncthreads();
        float off = 0.f;
#pragma unroll
        for (int pp = 0; pp < 3; ++pp) off += (pp < p) ? tot[pp * 128 + d] : 0.f;
#pragma unroll
        for (int i = 0; i < 16; ++i) bb[(16 * p + i) * RS + d] = vals[i] + off;
    }
    __syncthreads();
    {
        const int I = tid >> 7, p = tid & 127, tr = 16 * I + (p >> 3), s0 = (p & 7) * 2, sr = 16 * I + s0; float a0 = 0.f, a1 = 0.f;
        for (int d = 0; d < 128; d += 4) { const f32x4 qt = *(const LAS f32x4*)(q + tr * RS + d), bt = *(const LAS f32x4*)(bb + tr * RS + d);
            const f32x4 k0 = *(const LAS f32x4*)(kk + sr * RS + d), b0 = *(const LAS f32x4*)(bb + sr * RS + d), k1 = *(const LAS f32x4*)(kk + (sr + 1) * RS + d), b1 = *(const LAS f32x4*)(bb + (sr + 1) * RS + d);
#pragma unroll
            for (int j = 0; j < 4; ++j) { a0 += qt[j] * k0[j] * ex2(fminf(bt[j] - b0[j], 0.f)); a1 += qt[j] * k1[j] * ex2(fminf(bt[j] - b1[j], 0.f)); } }
        Am[tr * AS + sr] = (s0 <= (p >> 3)) ? a0 : 0.f; Am[tr * AS + sr + 1] = (s0 + 1 <= (p >> 3)) ? a1 : 0.f;
        for (int idx = tid; idx < 1536; idx += 512) { const int blk = idx >> 8, e = idx & 255; const int bi = blk < 3 ? 0 : (blk < 5 ? 1 : 2), bj = blk < 3 ? blk + 1 : (blk < 5 ? blk - 1 : 3);
            Am[(16 * bi + (e >> 4)) * AS + 16 * bj + (e & 15)] = 0.f; }
    }
#pragma unroll 1
    for (int I = 1; I < 4; ++I) {
        __syncthreads();
        { const int nrows = 16 * I + 16; const LAS float* rr = bb + (16 * I - 1) * RS;
          for (int idx = tid; idx < nrows * 128; idx += 512) { const int row = idx >> 7, d = idx & 127; const float r = rr[d];
              if (row < 16 * I) X[row * RS + d] = kk[row * RS + d] * ex2(fminf(r - bb[row * RS + d], 0.f));
              else X[(48 + row - 16 * I) * RS + d] = q[row * RS + d] * ex2(fminf(bb[row * RS + d] - r, 0.f)); } }
        __syncthreads();
        { const int tp = tid & 15, sg = tid >> 4;
          for (int s = sg; s < 16 * I; s += 32) { float acc = 0.f;
              for (int d = 0; d < 128; d += 4) { const f32x4 x = *(const LAS f32x4*)(X + (48 + tp) * RS + d), y = *(const LAS f32x4*)(X + s * RS + d); acc += (x[0] * y[0] + x[1] * y[1]) + (x[2] * y[2] + x[3] * y[3]); }
              Am[(16 * I + tp) * AS + s] = acc; } }
    }
    __syncthreads();
    for (int idx = tid; idx < 1024; idx += 512) { const int t = idx >> 4, d0 = (idx & 15) * 8; float qd[8];
        const u32x4 vw = *(const u32x4*)(P + (size_t)(tok0 + t) * PLD + PC_BI + h * 128 + d0);
#pragma unroll
        for (int j = 0; j < 8; ++j) qd[j] = q[t * RS + d0 + j] * ex2(bb[t * RS + d0 + j]);
        u32x4 wv; wv.x = pk2(qd[0], qd[1]); wv.y = pk2(qd[2], qd[3]); wv.z = pk2(qd[4], qd[5]); wv.w = pk2(qd[6], qd[7]);
        *(u32x4*)(P + (size_t)(tok0 + t) * PLD + PC_BQ + h * 128 + d0) = wv;
        vT[(d0 + 0) * TS + t] = (bf16_t)(vw.x & 0xffffu); vT[(d0 + 1) * TS + t] = (bf16_t)(vw.x >> 16); vT[(d0 + 2) * TS + t] = (bf16_t)(vw.y & 0xffffu); vT[(d0 + 3) * TS + t] = (bf16_t)(vw.y >> 16);
        vT[(d0 + 4) * TS + t] = (bf16_t)(vw.z & 0xffffu); vT[(d0 + 5) * TS + t] = (bf16_t)(vw.z >> 16); vT[(d0 + 6) * TS + t] = (bf16_t)(vw.w & 0xffffu); vT[(d0 + 7) * TS + t] = (bf16_t)(vw.w >> 16); }
    if (tid < 128) ((float*)(wsp(a) + WS_DEC))[(size_t)item * 128 + tid] = ex2(bb[63 * RS + tid]);
    __syncthreads();
    for (int idx = tid; idx < 8192; idx += 512) { const int t = idx >> 7, d = idx & 127;
        const float kd = kk[t * RS + d] * ex2(bb[63 * RS + d] - bb[t * RS + d]);
        kT[d * TS + t] = (bf16_t)(pk2(kd, 0.f) & 0xffffu); }
    __syncthreads();
    {
        f32x4 acc[8];
#pragma unroll
        for (int et = 0; et < 8; ++et) acc[et] = (f32x4){0.f, 0.f, 0.f, 0.f};
#pragma unroll
        for (int ks = 0; ks < 2; ++ks) { const bf16x8 af = *(const LAS bf16x8*)(kT + (w * 16 + fr) * TS + ks * 32 + fq * 8);
#pragma unroll
            for (int et = 0; et < 8; ++et) acc[et] = mfma16(af, *(const LAS bf16x8*)(vT + (et * 16 + fr) * TS + ks * 32 + fq * 8), acc[et]); }
        float* st = (float*)(wsp(a) + WS_Z) + (size_t)item * 16384 + (size_t)fr * 128 + w * 16 + fq * 4;
#pragma unroll
        for (int et = 0; et < 8; ++et) *(f32x4*)(st + (size_t)et * 16 * 128) = acc[et];
    }
    {
        f32x4 acc[4];
#pragma unroll
        for (int tt = 0; tt < 4; ++tt) acc[tt] = (f32x4){0.f, 0.f, 0.f, 0.f};
#pragma unroll
        for (int ks = 0; ks < 2; ++ks) { const bf16x8 af = *(const LAS bf16x8*)(vT + (w * 16 + fr) * TS + ks * 32 + fq * 8);
#pragma unroll
            for (int tt = 0; tt < 4; ++tt) { const LAS float* ap = Am + (tt * 16 + fr) * AS + ks * 32 + fq * 8; const f32x4 x0 = *(const LAS f32x4*)ap, x1 = *(const LAS f32x4*)(ap + 4);
                u32x4 bw; bw.x = pk2(x0[0], x0[1]); bw.y = pk2(x0[2], x0[3]); bw.z = pk2(x1[0], x1[1]); bw.w = pk2(x1[2], x1[3]);
                acc[tt] = mfma16(af, __builtin_bit_cast(bf16x8, bw), acc[tt]); } }
#pragma unroll
        for (int tt = 0; tt < 4; ++tt) { u32x2 wv; wv.x = pk2(acc[tt][0], acc[tt][1]); wv.y = pk2(acc[tt][2], acc[tt][3]);
            *(u32x2*)(P + (size_t)(tok0 + tt * 16 + fr) * PLD + PC_BF + h * 128 + w * 16 + fq * 4) = wv; }
    }
    __syncthreads();
}
__device__ __forceinline__ void hgrn_scan(const Args& a) {
    const int gtid = bidx() * 512 + tidx(), GT = gdim() * 512; float* st = (float*)(wsp(a) + WS_Z); const float* dec = (const float*)(wsp(a) + WS_DEC);
    for (int idx = gtid; idx < 32 * 16384; idx += GT) { const int bh = idx >> 14, de = idx & 16383, d = de & 127;
        float kv[32], dc[32];
#pragma unroll
        for (int c = 0; c < 32; ++c) { const size_t ch = (size_t)bh * 32 + c; kv[c] = st[ch * 16384 + de]; dc[c] = dec[ch * 128 + d]; }
        float S = 0.f;
#pragma unroll
        for (int c = 0; c < 32; ++c) { const size_t ch = (size_t)bh * 32 + c; st[ch * 16384 + de] = S; S = dc[c] * S + kv[c]; } }
}
__device__ __forceinline__ void hgrn_stage3(const Args& a, int l, int item, int nitem, f32x4 (&sv)[8], LAS unsigned char* lds) {
    constexpr int TS2 = 136;
    LAS bf16_t* ST = (LAS bf16_t*)lds; LAS float* red = (LAS float*)(lds + 128 * TS2 * 2);
    const int tid = tidx(), lane = tid & 63, w = tid >> 6, fr = lane & 15, fq = lane >> 4; const int b = item >> 7, h = (item >> 5) & 3, c = item & 31; const int tok0 = b * SEQ + c * 64;
    const bf16_t* P = (const bf16_t*)(wsp(a) + WS_PROJ); const float* st = (const float*)(wsp(a) + WS_Z) + (size_t)item * 16384;
    bf16x8 qf[4][4];
#pragma unroll
    for (int ks = 0; ks < 4; ++ks)
#pragma unroll
        for (int tt = 0; tt < 4; ++tt) qf[ks][tt] = ld8(P + (size_t)(tok0 + tt * 16 + fr) * PLD + PC_BQ + h * 128 + ks * 32 + fq * 8);
    u32x2 iwv[4], gwv[4];
#pragma unroll
    for (int tt = 0; tt < 4; ++tt) { const bf16_t* row = P + (size_t)(tok0 + tt * 16 + fr) * PLD + h * 128 + w * 16 + fq * 4; iwv[tt] = *(const u32x2*)(row + PC_BF); gwv[tt] = *(const u32x2*)(row + PC_BG); }
#pragma unroll
    for (int i = 0; i < 8; ++i) { const int ii = tid + i * 512; u32x2 p; p.x = pk2(sv[i][0], sv[i][1]); p.y = pk2(sv[i][2], sv[i][3]); *(LAS u32x2*)(ST + (ii >> 5) * TS2 + (ii & 31) * 4) = p; }
    if (nitem < 1024) { const float* st2 = (const float*)(wsp(a) + WS_Z) + (size_t)nitem * 16384;
#pragma unroll
        for (int i = 0; i < 8; ++i) { const int ii = tid + i * 512; sv[i] = *(const f32x4*)(st2 + (ii >> 5) * 128 + (ii & 31) * 4); } }
    __syncthreads();
    f32x4 acc[4];
#pragma unroll
    for (int tt = 0; tt < 4; ++tt) acc[tt] = (f32x4){0.f, 0.f, 0.f, 0.f};
#pragma unroll
    for (int ks = 0; ks < 4; ++ks) { const bf16x8 af = *(const LAS bf16x8*)(ST + (w * 16 + fr) * TS2 + ks * 32 + fq * 8);
#pragma unroll
        for (int tt = 0; tt < 4; ++tt) acc[tt] = mfma16(af, qf[ks][tt], acc[tt]); }
    float o[4][4];
#pragma unroll
    for (int tt = 0; tt < 4; ++tt) { const u32x2 iw = iwv[tt];
        o[tt][0] = acc[tt][0] + bflo(iw.x); o[tt][1] = acc[tt][1] + bfhi(iw.x); o[tt][2] = acc[tt][2] + bflo(iw.y); o[tt][3] = acc[tt][3] + bfhi(iw.y);
        float ss = o[tt][0] * o[tt][0] + o[tt][1] * o[tt][1] + o[tt][2] * o[tt][2] + o[tt][3] * o[tt][3];
        ss = rsum_fq(ss);
        if (fq == 0) red[(tt * 16 + fr) * 8 + w] = ss; }
    __syncthreads();
    const float* ng = (const float*)inp(a, 13) + l * 128; const f32x4 gn = *(const f32x4*)(ng + w * 16 + fq * 4);
    bf16_t* yb = (bf16_t*)(wsp(a) + WS_YB);
#pragma unroll
    for (int tt = 0; tt < 4; ++tt) { const LAS float* rp = red + (tt * 16 + fr) * 8; const f32x4 r0 = *(const LAS f32x4*)rp, r1 = *(const LAS f32x4*)(rp + 4);
        const float tot = ((r0[0] + r0[1]) + (r0[2] + r0[3])) + ((r1[0] + r1[1]) + (r1[2] + r1[3])); const float rs = rsqrtf(tot * (1.f / 128.f) + 1e-6f);
        const u32x2 gw = gwv[tt];
        const float g0 = bflo(gw.x), g1 = bfhi(gw.x), g2 = bflo(gw.y), g3 = bfhi(gw.y);
        u32x2 wv; wv.x = pk2(o[tt][0] * rs * gn[0] * g0 * sigm(g0), o[tt][1] * rs * gn[1] * g1 * sigm(g1)); wv.y = pk2(o[tt][2] * rs * gn[2] * g2 * sigm(g2), o[tt][3] * rs * gn[3] * g3 * sigm(g3));
        *(u32x2*)(yb + (size_t)(tok0 + tt * 16 + fr) * 512 + h * 128 + w * 16 + fq * 4) = wv; }
    __syncthreads();
}

__device__ __forceinline__ void cmp_gemm2(const Args& a, int l) {
    const int gtid = bidx() * 512 + tidx(), GT = gdim() * 512;
    const bf16_t* hid = (const bf16_t*)(wsp(a) + WS_HID); const float* w2 = (const float*)inp(a, 11) + (size_t)l * 2 * 256 * 64;
    bf16_t* kc = (bf16_t*)(wsp(a) + WS_KCMP); bf16_t* vc = (bf16_t*)(wsp(a) + WS_VCMPT);
    for (int idx = gtid; idx < 2048 * 64; idx += GT) { const int r = idx >> 6, d = idx & 63;
        const bf16_t* h0 = hid + (size_t)r * 256; const bf16_t* h1 = hid + (size_t)(2048 + r) * 256; const float* w0 = w2 + d; const float* w1 = w2 + 16384 + d; float s0 = 0.f, s1 = 0.f;
#pragma unroll 1
        for (int k0 = 0; k0 < 256; k0 += 32) { u32x4 ha[4], hb[4]; float wa[32], wb[32];
#pragma unroll
            for (int q = 0; q < 4; ++q) { ha[q] = *(const u32x4*)(h0 + k0 + q * 8); hb[q] = *(const u32x4*)(h1 + k0 + q * 8); }
#pragma unroll
            for (int j = 0; j < 32; ++j) { wa[j] = w0[(k0 + j) * 64]; wb[j] = w1[(k0 + j) * 64]; }
#pragma unroll
            for (int q = 0; q < 4; ++q) {
                s0 += bflo(ha[q].x) * wa[q * 8 + 0] + bfhi(ha[q].x) * wa[q * 8 + 1] + bflo(ha[q].y) * wa[q * 8 + 2] + bfhi(ha[q].y) * wa[q * 8 + 3] + bflo(ha[q].z) * wa[q * 8 + 4] + bfhi(ha[q].z) * wa[q * 8 + 5] + bflo(ha[q].w) * wa[q * 8 + 6] + bfhi(ha[q].w) * wa[q * 8 + 7];
                s1 += bflo(hb[q].x) * wb[q * 8 + 0] + bfhi(hb[q].x) * wb[q * 8 + 1] + bflo(hb[q].y) * wb[q * 8 + 2] + bfhi(hb[q].y) * wb[q * 8 + 3] + bflo(hb[q].z) * wb[q * 8 + 4] + bfhi(hb[q].z) * wb[q * 8 + 5] + bflo(hb[q].w) * wb[q * 8 + 6] + bfhi(hb[q].w) * wb[q * 8 + 7]; } }
        kc[(size_t)(r >> 7) * 8192 + kfrag_off(r & 127, d, 2)] = (bf16_t)(pk2(s0, 0.f) & 0xffffu);
        vc[(size_t)(r >> 7) * 8192 + vfrag_off(r & 127, d)] = (bf16_t)(pk2(s1, 0.f) & 0xffffu); }
}

struct MaskSel { unsigned mymask; int jb, tcol; __device__ __forceinline__ bool operator()(int, int key) const { return ((mymask >> jb) & 1u) && key <= tcol; } };
struct MaskWin { int tcol; __device__ __forceinline__ bool operator()(int, int key) const { return key <= tcol && key > tcol - 256; } };
struct MaskCausal2 { int t0, t1; __device__ __forceinline__ bool operator()(int ct, int key) const { return key <= (ct ? t1 : t0); } };

__device__ __forceinline__ void nsa_item(const Args& a, int item, int lane) {
    const int fr = lane & 15, fq = lane >> 4;
    const int t4 = ((item & 511) + 128 * (item >> 11)) & 511, g = (item >> 9) & 1, b = item >> 10;
    const int t0 = t4 * 4, tq = fr >> 2, r = fr & 3, tcol = t0 + tq, tok = b * SEQ + tcol, head = g * 4 + r;
    const bf16_t* P = (const bf16_t*)(wsp(a) + WS_PROJ); const f32x2* ropeN = (const f32x2*)(wsp(a) + WS_ROPEN);
    const float cs = 0.125f * LOG2E;
    const bf16_t* qp = P + (size_t)tok * PLD + PC_Q + head * 64 + fq * 8;
    bf16x8 qg[1][2], qr[1][2]; qg[0][0] = ld8(qp); qg[0][1] = ld8(qp + 32); qr[0][1] = qg[0][1];
    { const u32x4 own = __builtin_bit_cast(u32x4, qg[0][0]); u32x4 par;
      par.x = (unsigned)__shfl_xor((int)own.x, 16); par.y = (unsigned)__shfl_xor((int)own.y, 16); par.z = (unsigned)__shfl_xor((int)own.z, 16); par.w = (unsigned)__shfl_xor((int)own.w, 16);
      u32x4 res = own;
      if (fq < 2) { const float sgn = (fq == 0) ? -1.f : 1.f; const unsigned ow[4] = {own.x, own.y, own.z, own.w}, pw[4] = {par.x, par.y, par.z, par.w}; unsigned rw[4];
#pragma unroll
          for (int j = 0; j < 4; ++j) { const f32x2 c0 = ropeN[tok * 8 + 2 * j], c1 = ropeN[tok * 8 + 2 * j + 1];
              rw[j] = pk2(bflo(ow[j]) * c0.x + sgn * bflo(pw[j]) * c0.y, bfhi(ow[j]) * c1.x + sgn * bfhi(pw[j]) * c1.y); }
          res = (u32x4){rw[0], rw[1], rw[2], rw[3]}; }
      qr[0][0] = __builtin_bit_cast(bf16x8, res); }
    const int gb = g * 8 + b;
    const bf16_t* kc = (const bf16_t*)(wsp(a) + WS_KCMP) + (size_t)gb * 8192; const bf16_t* vc = (const bf16_t*)(wsp(a) + WS_VCMPT) + (size_t)gb * 8192;
    const int nv = tcol >= 31 ? ((tcol - 31) >> 4) + 1 : 0;
    float sc[4][8]; float mx = -1.0e30f;
#pragma unroll
    for (int s4 = 0; s4 < 4; ++s4) {
#pragma unroll
        for (int u = 0; u < 2; ++u) { f32x4 s = (f32x4){0.f, 0.f, 0.f, 0.f};
#pragma unroll
            for (int dc = 0; dc < 2; ++dc) s = mfma16(ld8(kc + ((s4 * 2 + u) * 2 + dc) * 512 + lane * 8), qg[0][dc], s);
#pragma unroll
            for (int j = 0; j < 4; ++j) { const int n = s4 * 32 + fq * 8 + u * 4 + j; const float v = (n < nv) ? s[j] * cs : -1.0e30f; sc[s4][u * 4 + j] = v; mx = fmaxf(mx, v); } } }
    mx = rmax_fq(mx);
    float lsum = 0.f;
#pragma unroll
    for (int s4 = 0; s4 < 4; ++s4)
#pragma unroll
        for (int e = 0; e < 8; ++e) { const int n = s4 * 32 + fq * 8 + e; const float p = (n < nv) ? ex2(sc[s4][e] - mx) : 0.f; sc[s4][e] = p; lsum += p; }
    lsum = rsum_fq(lsum);
    const float linv = lsum > 0.f ? 1.f / lsum : 0.f;
    f32x4 ocmp[4];
#pragma unroll
    for (int dt = 0; dt < 4; ++dt) ocmp[dt] = (f32x4){0.f, 0.f, 0.f, 0.f};
#pragma unroll
    for (int s4 = 0; s4 < 4; ++s4) {
#pragma unroll
        for (int e = 0; e < 8; ++e) sc[s4][e] *= linv;
        u32x4 pw; pw.x = pk2(sc[s4][0], sc[s4][1]); pw.y = pk2(sc[s4][2], sc[s4][3]); pw.z = pk2(sc[s4][4], sc[s4][5]); pw.w = pk2(sc[s4][6], sc[s4][7]);
        const bf16x8 pb = __builtin_bit_cast(bf16x8, pw);
#pragma unroll
        for (int dt = 0; dt < 4; ++dt) ocmp[dt] = mfma16(ld8(vc + (s4 * 4 + dt) * 512 + lane * 8), pb, ocmp[dt]);
#pragma unroll
        for (int e = 0; e < 8; ++e) sc[s4][e] = rsum_quad(sc[s4][e]);
    }
    float val[8];
    const int cur = tcol >> 6;
#pragma unroll
    for (int s4 = 0; s4 < 4; ++s4) { const float prev = __shfl(sc[s4][7], (lane - 16) & 63); const float prevm1 = (s4 > 0) ? __shfl(sc[s4 > 0 ? s4 - 1 : 0][7], (lane - 16) & 63) : 0.f;
        const float pm1 = (fq > 0) ? prev : prevm1;
#pragma unroll
        for (int h2 = 0; h2 < 2; ++h2) { const float m1 = h2 ? sc[s4][3] : pm1;
            const float imp = 0.5f * m1 + sc[s4][4 * h2] + sc[s4][4 * h2 + 1] + sc[s4][4 * h2 + 2] + 0.5f * sc[s4][4 * h2 + 3];
            const int jb = 8 * s4 + 2 * fq + h2; const bool vld = (jb * 64 <= tcol), forced = (jb == 0) || (jb == cur) || (jb == cur - 1);
            val[s4 * 2 + h2] = vld ? (forced ? 1.0e9f : imp) : -1.0e9f; } }
    int rank[8];
#pragma unroll
    for (int k = 0; k < 8; ++k) rank[k] = 0;
#pragma unroll
    for (int dq = 0; dq < 4; ++dq) {
#pragma unroll
        for (int k2 = 0; k2 < 8; ++k2) { const float ov = __shfl(val[k2], fr | (dq << 4)); const int ojb = 8 * (k2 >> 1) + 2 * dq + (k2 & 1);
#pragma unroll
            for (int k = 0; k < 8; ++k) { const int jb = 8 * (k >> 1) + 2 * fq + (k & 1); rank[k] += (ov > val[k] || (ov == val[k] && ojb < jb)) ? 1 : 0; } } }
    unsigned mymask = 0u;
#pragma unroll
    for (int k = 0; k < 8; ++k) { const int jb = 8 * (k >> 1) + 2 * fq + (k & 1); if (val[k] > -0.5e9f && rank[k] < 8) mymask |= (1u << jb); }
    mymask |= (unsigned)__shfl_xor((int)mymask, 16); mymask |= (unsigned)__shfl_xor((int)mymask, 32);
    unsigned U = (unsigned)__builtin_amdgcn_readlane((int)mymask, 0) | (unsigned)__builtin_amdgcn_readlane((int)mymask, 4) | (unsigned)__builtin_amdgcn_readlane((int)mymask, 8) | (unsigned)__builtin_amdgcn_readlane((int)mymask, 12);
    const bf16_t* vtn = (const bf16_t*)(wsp(a) + WS_VTN);
    FAS ss[1]; fas_init(ss[0]);
    const bf16_t* kfn = (const bf16_t*)(wsp(a) + WS_KFN);
    { const bf16_t* ksb = kfn + (size_t)((0 * 8 + b) * 2 + g) * 131072; const bf16_t* const kb[2] = {ksb, ksb + 512}; const int kcs[2] = {1024, 1024};
      const bf16_t* vt = vtn + (size_t)((0 * 2 + g) * 8 + b) * 131072;
      while (U) { const int jb = __builtin_ctz(U); U &= U - 1u; const MaskSel mk{mymask, jb, tcol};
          fa_step2<1, 2>(ss, qr, kb, kcs, vt, jb * 64, cs, true, true, mk, lane); } }
    FAS sw[1]; fas_init(sw[0]);
    { const bf16_t* kwb = kfn + (size_t)((1 * 8 + b) * 2 + g) * 131072; const bf16_t* const kb[2] = {kwb, kwb + 512}; const int kcs[2] = {1024, 1024};
      const bf16_t* vt = vtn + (size_t)((1 * 2 + g) * 8 + b) * 131072; const MaskWin mk{tcol};
      int k0 = t0 - 255; if (k0 < 0) k0 = 0; k0 &= ~31;
      for (; k0 + 32 <= t0 + 3; k0 += 64) fa_step2<1, 2>(sw, qr, kb, kcs, vt, k0, cs, true, true, mk, lane);
      if (k0 <= t0 + 3) fa_step<1, 2>(sw, qr, kb, kcs, vt, k0, cs, true, mk, lane); }
    const bf16_t* gp = P + (size_t)tok * PLD + PC_GATE + head * 3;
    const float g0 = sigm(bf2f(gp[0])), g1 = sigm(bf2f(gp[1])) * (ss[0].l > 0.f ? 1.f / ss[0].l : 0.f), g2 = sigm(bf2f(gp[2])) * (sw[0].l > 0.f ? 1.f / sw[0].l : 0.f);
    bf16_t* ya = (bf16_t*)(wsp(a) + WS_YA) + (size_t)tok * 512 + head * 64;
#pragma unroll
    for (int dt = 0; dt < 4; ++dt) { float o[4];
#pragma unroll
        for (int j = 0; j < 4; ++j) { o[j] = 0.f;
#ifdef MK_NB
            if (MK_NB & 1) o[j] += g0 * ocmp[dt][j]; if (MK_NB & 2) o[j] += g1 * ss[0].o[dt][j]; if (MK_NB & 4) o[j] += g2 * sw[0].o[dt][j];
#else
            o[j] = g0 * ocmp[dt][j] + g1 * ss[0].o[dt][j] + g2 * sw[0].o[dt][j];
#endif
        }
#ifdef MK_SAN
#pragma unroll
        for (int j = 0; j < 4; ++j) if (!(fabsf(o[j]) < 1.0e6f)) o[j] = 0.f;
#endif
        u32x2 w; w.x = pk2(o[0], o[1]); w.y = pk2(o[2], o[3]); *(u32x2*)(ya + dt * 16 + fq * 4) = w; }
}

__device__ __forceinline__ void mla_item(const Args& a, int item, int wave, int lane) {
    const int fr = lane & 15, fq = lane >> 4; const int bh = item & 63, qb = item >> 6, b = bh >> 3, h = bh & 7;
    const int q0 = qb * 256 + wave * 32;
    const bf16_t* mq = (const bf16_t*)(wsp(a) + WS_MQ); const bf16_t* kn = (const bf16_t*)(wsp(a) + WS_KNOPE); const bf16_t* kpe = (const bf16_t*)(wsp(a) + WS_KPE); const bf16_t* vtm = (const bf16_t*)(wsp(a) + WS_VTM);
    bf16x8 qf[2][3];
#pragma unroll
    for (int ct = 0; ct < 2; ++ct)
#pragma unroll
        for (int dc = 0; dc < 3; ++dc) qf[ct][dc] = ld8(mq + (size_t)(b * SEQ + q0 + ct * 16 + fr) * 768 + h * 96 + dc * 32 + fq * 8);
    const bf16_t* knb = kn + (size_t)(h * 8 + b) * 131072; const bf16_t* const kb[3] = {knb, knb + 512, kpe + (size_t)b * 65536}; const int kcs[3] = {1024, 1024, 512};
    const bf16_t* vt = vtm + (size_t)(h * 8 + b) * 131072;
    FAS st[2]; fas_init(st[0]); fas_init(st[1]);
    const MaskCausal2 mk{q0 + fr, q0 + 16 + fr};
    { int k0 = 0;
      for (; k0 + 32 <= q0; k0 += 64) fa_step2<2, 3>(st, qf, kb, kcs, vt, k0, 1.0f, false, k0 + 63 > q0, mk, lane);
      if (k0 <= q0) fa_step<2, 3>(st, qf, kb, kcs, vt, k0, 1.0f, k0 + 31 > q0, mk, lane); }
    bf16_t* yc = (bf16_t*)(wsp(a) + WS_YC);
#pragma unroll
    for (int ct = 0; ct < 2; ++ct) { const float inv = st[ct].l > 0.f ? 1.f / st[ct].l : 0.f; bf16_t* yp = yc + (size_t)(b * SEQ + q0 + ct * 16 + fr) * 512 + h * 64;
#pragma unroll
        for (int dt = 0; dt < 4; ++dt) { u32x2 w; w.x = pk2(st[ct].o[dt][0] * inv, st[ct].o[dt][1] * inv); w.y = pk2(st[ct].o[dt][2] * inv, st[ct].o[dt][3] * inv); *(u32x2*)(yp + dt * 16 + fq * 4) = w; } }
}

__device__ __forceinline__ void cmp_bias(const Args& a, int l) {
    const int lane = tidx() & 63, gw = bidx() * 8 + (tidx() >> 6); if (gw >= 512) return;
    const int which = gw >> 8, n = gw & 255; const bf16_t* w = (const bf16_t*)(wsp(a) + WS_W) + W_CMP + (size_t)(which * 256 + n) * 2048;
    const float* pe = (const float*)inp(a, 9) + (size_t)(l * 2 + which) * 2048; float s = 0.f;
#pragma unroll
    for (int i = 0; i < 4; ++i) { const int k = i * 512 + lane * 8; const u32x4 ww = *(const u32x4*)(w + k); const f32x4 p0 = *(const f32x4*)(pe + k), p1 = *(const f32x4*)(pe + k + 4);
        s += bflo(ww.x) * p0[0] + bfhi(ww.x) * p0[1] + bflo(ww.y) * p0[2] + bfhi(ww.y) * p0[3] + bflo(ww.z) * p1[0] + bfhi(ww.z) * p1[1] + bflo(ww.w) * p1[2] + bfhi(ww.w) * p1[3]; }
    s = wave_sum(s); if (lane == 0) ((float*)(wsp(a) + WS_CBIAS))[gw] = s;
}

__device__ __forceinline__ bool store_job(const Args& a, int kind, int j, g8::Desc& d, g8::EpiStore& e) {
    unsigned char* ws = wsp(a); const bf16_t* W = (const bf16_t*)(ws + WS_W); bf16_t* xb = (bf16_t*)(ws + WS_XB); bf16_t* P = (bf16_t*)(ws + WS_PROJ);
    d.aBS1 = d.aBS2 = d.bBS1 = d.bBS2 = 0; d.nB = 1; d.nB2 = 1; d.boff = 0;
    e.oBS1 = e.oBS2 = 0; e.split_shift = 0; e.split_stride = 0; e.rowscale = nullptr; e.colscale = nullptr; e.bias = nullptr; e.act = 0; e.nB2 = 1; e.lay = 0;
    if (kind == 1) {
        if (j == 0) { d.A = (const bf16_t*)(ws + WS_MEMB); d.Bt = W + W_XK; d.lda = d.ldb = d.K = 1024; d.nM = 8; d.nN = 4; d.boff = 128; e.O = (bf16_t*)(ws + WS_XAK); e.ldc = 1024; return true; }
        if (j == 1) { d.A = W + W_XV; d.Bt = (const bf16_t*)(ws + WS_MEMB); d.lda = d.ldb = d.K = 1024; d.nM = 4; d.nN = 1; d.nB = 8; d.bBS1 = 256 * 1024; d.boff = 160; e.O = (bf16_t*)(ws + WS_XAVT); e.oBS1 = 1024 * 256; e.ldc = 256; return true; }
        return false;
    }
    if (kind == 4) {
        if (j == 0) { d.A = xb; d.Bt = W + W_IN; d.lda = d.ldb = d.K = 1024; d.nM = 64; d.nN = 26; e.O = P; e.ldc = PLD; return true; }
        if (j == 1) { d.A = xb; d.Bt = W + W_IN + 6656 * 1024; d.lda = d.ldb = d.K = 1024; d.nM = 64; d.nN = 1; d.boff = 128; e.O = (bf16_t*)(ws + WS_KCG); e.ldc = 64; e.split_shift = 6; e.split_stride = (long)T * 64; return true; }
        if (j == 2) { d.A = W + W_IN + 6912 * 1024; d.Bt = xb; d.lda = d.ldb = d.K = 1024; d.nM = 1; d.nN = 64; d.boff = 192; e.O = (bf16_t*)(ws + WS_VTN); e.ldc = T; e.lay = 1; return true; }
        return false;
    }
    if (kind == 5) {
        if (j < 2) { d.A = (const bf16_t*)(ws + WS_KCG) + (size_t)j * 2 * T * 64; d.Bt = W + W_CMP + j * 256 * 2048; d.lda = 1024; d.ldb = 2048; d.K = 2048; d.nM = 8; d.nN = 1; d.boff = j * 8;
            e.O = (bf16_t*)(ws + WS_HID) + (size_t)j * 2048 * 256; e.ldc = 256; e.bias = (const float*)(ws + WS_CBIAS) + j * 256; e.act = 1; return true; }
        return false;
    }
    if (kind == 6) {
        if (j == 0) { d.A = P + PC_CKV; d.Bt = W + W_KN; d.lda = PLD; d.ldb = 256; d.K = 256; d.nM = 64; d.nN = 2; d.boff = 192; e.O = (bf16_t*)(ws + WS_KNOPE); e.ldc = 512; e.rowscale = (const float*)(ws + WS_RSKV); e.lay = 2; return true; }
        if (j == 1) { d.A = W + W_VM; d.Bt = P + PC_CKV; d.lda = 256; d.ldb = PLD; d.K = 256; d.nM = 2; d.nN = 64; d.boff = 64; e.O = (bf16_t*)(ws + WS_VTM); e.ldc = T; e.colscale = (const float*)(ws + WS_RSKV); e.lay = 1; return true; }
        return false;
    }
    if (kind == 11) {
        if (j == 0) { d.A = xb; d.Bt = W + W_XQ; d.lda = d.ldb = d.K = 1024; d.nM = 64; d.nN = 4; e.O = (bf16_t*)(ws + WS_XQ); e.ldc = 1024; return true; }
        return false;
    }
    if (kind == 13) {
        if (j == 0) { d.A = (const bf16_t*)(ws + WS_XP); d.lda = 1024; d.Bt = (const bf16_t*)(ws + WS_XAVT); d.ldb = 256; d.K = 256; d.nM = 64; d.nN = 4;
            e.O = (bf16_t*)(ws + WS_XO); e.ldc = 1024; return true; }
        return false;
    }
    return false;
}

constexpr int NPL = 13, NPH = 1 + NLAYER * NPL;
__global__ void __launch_bounds__(512, 2) mk_fwd(Args a) {
    extern __shared__ __attribute__((aligned(16))) unsigned char lds_raw[];
    LAS unsigned char* lds = (LAS unsigned char*)lds_raw;
    volatile LAS unsigned* bst = (volatile LAS unsigned*)(lds + LDS_BYTES - 64);
    if (threadIdx.x == 0) { bst[0] = 0u; bst[1] = 0u; }
    __syncthreads();
#pragma unroll 1
    for (int ph = a.ph_lo; ph < a.ph_hi; ++ph) {
        unsigned char* ws = wsp(a);
        const int tid = tidx(), lane = tid & 63, wave = __builtin_amdgcn_readfirstlane(tid >> 6), G = gdim();
        const bf16_t* W = (const bf16_t*)(ws + WS_W); bf16_t* xb = (bf16_t*)(ws + WS_XB); bf16_t* P = (bf16_t*)(ws + WS_PROJ);
        if (ph == 0) {
#ifndef NO_INIT
            phase_init(a);
#endif
        }
        else {
            const int l = (ph - 1) / NPL, k = (ph - 1) % NPL;
            int kind;
            switch (k) { case 0: kind = 0; break; case 1: case 11: kind = 1; break; case 2: case 8: case 10: case 12: kind = 2; break; case 3: kind = 4; break; case 4: kind = 5; break; case 5: kind = 6; break;
                         case 6: kind = 7; break; case 7: kind = 8; break; default: kind = 11; break; }
#ifndef NO_CONV
            if (kind == 0) phase_conv(a, l, lds);
#endif
#ifndef NO_UP
            if (kind == 1) { g8::Desc d; d.A = xb; d.Bt = W + (k == 1 ? W_UP1 : W_UP2); d.aBS1 = d.aBS2 = d.bBS1 = d.bBS2 = 0; d.lda = d.ldb = d.K = 1024; d.nM = 64; d.nN = 22; d.nB = 1; d.nB2 = 1; d.boff = 0;
                g8::EpiSwiglu e{(bf16_t*)(ws + WS_H)}; g8::desc_defaults(d); g8::gemm_phase(lds, d, e); if (k == 1) cmp_bias(a, l); }
#endif
#ifndef NO_RESID
            if (kind == 2) { g8::Desc d; d.aBS1 = d.aBS2 = d.bBS1 = d.bBS2 = 0; d.nM = 64; d.nN = 4; d.nB = 1; d.nB2 = 1; d.boff = 0; float s = 1.f; int j = 0;
                if (k == 2 || k == 12) { d.A = (const bf16_t*)(ws + WS_H); d.Bt = W + (k == 2 ? W_DN1 : W_DN2); d.lda = d.ldb = d.K = DFF; s = 0.5f; j = (k == 2) ? 0 : 3; }
                else if (k == 8) { d.A = xb; d.Bt = W + W_OUT; d.lda = d.ldb = d.K = 1024; j = 1; }
                else { d.A = (const bf16_t*)(ws + WS_XO); d.Bt = W + W_XO; d.lda = d.ldb = d.K = 1024; j = 2; }
                g8::EpiLn e{(l == 0 && j == 0) ? (const float*)inp(a, 0) : (const float*)outp(a), outp(a), xb, (const float*)inp(a, 3) + (size_t)(l * 4 + j) * DM, (const float*)inp(a, 4) + (size_t)(l * 4 + j) * DM, s,
                            (unsigned long long*)(ws + WS_XBUF), (unsigned*)(ws + WS_CNT), 16u * (unsigned)(l * 4 + j + 1)};
                g8::desc_defaults(d); g8::gemm_phase(lds, d, e); }
#endif
#ifndef NO_MLAQ
            if (kind == 6) { g8::Desc d; d.A = P + PC_CQ; d.Bt = W + W_UQ; d.aBS1 = d.aBS2 = d.bBS1 = d.bBS2 = 0; d.lda = PLD; d.ldb = 384; d.K = 384; d.nM = 64; d.nN = 3; d.nB = 1; d.nB2 = 1; d.boff = 0;
                g8::EpiMlaQ e{(bf16_t*)(ws + WS_MQ), (const float*)(ws + WS_RSQ), (const f32x2*)(ws + WS_ROPEM)}; g8::desc_defaults(d); g8::gemm_phase(lds, d, e); }
#endif
#ifndef NO_STORE
            if (kind == 1 || kind == 4 || kind == 5 || kind == 6 || kind == 11) {
                if (!(kind == 1 && k != 1)) {
#pragma unroll 1
                    for (int j = 0; j < 3; ++j) { g8::Desc d; g8::EpiStore e; if (!store_job(a, kind, j, d, e)) break; if (kind == 11 && j > 0) break; g8::desc_defaults(d); g8::gemm_phase(lds, d, e); } } }
#endif
            if (kind == 5) {
#ifndef NO_S1TOK
                s1_tokens(a);
#endif
#ifndef NO_H1
                {
                    unsigned* qctr = (unsigned*)(ws + WS_BAR) + 12288 + l * 64; volatile LAS int* qs = (volatile LAS int*)(lds + LDS_BYTES - 128);
                    for (;;) { if (tid == 0) *qs = (int)__hip_atomic_fetch_add(qctr, 1u, __ATOMIC_RELAXED, __HIP_MEMORY_SCOPE_AGENT);
                        __syncthreads(); const int it = *qs; __syncthreads(); if (it >= 1024) break; hgrn_stage1(a, l, it, lds); } }
#endif
            }
#ifndef NO_S2X
            if (kind == 6) { cmp_gemm2(a, l); hgrn_scan(a); }
#endif
            if (kind == 7) {
#ifndef NO_NSA
                { const int gw = bidx() * 8 + wave; for (int it = gw; it < 8192; it += G * 8) nsa_item(a, it, lane); }
#endif
#ifndef NO_MLA
                { const int bx = bidx(); if (bx < 256) { mla_item(a, bx, wave, lane); mla_item(a, 511 - bx, wave, lane); } }
#endif
#ifndef NO_H3
                { f32x4 hsv[8]; { const float* st0 = (const float*)(ws + WS_Z) + (size_t)bidx() * 16384;
#pragma unroll
                      for (int i = 0; i < 8; ++i) { const int ii = tid + i * 512; hsv[i] = *(const f32x4*)(st0 + (ii >> 5) * 128 + (ii & 31) * 4); } }
                  for (int it = bidx(); it < 1024; it += G) hgrn_stage3(a, l, it, it + G, hsv, lds); }
#endif
            }
#ifndef NO_MERGE
            if (kind == 8) {
#pragma unroll 1
                for (int i = 0; i < 3; ++i) { g8::Desc d; d.A = (const bf16_t*)(ws + WS_YA) + (size_t)i * T * 512; d.Bt = W + W_BR + i * 1024 * 512; d.aBS1 = d.aBS2 = d.bBS1 = d.bBS2 = 0; d.lda = d.ldb = d.K = 512; d.nM = 64; d.nN = 4; d.nB = 1; d.nB2 = 1; d.boff = 0;
                    g8::EpiMerge e{P, (float*)(ws + WS_Z), xb, i}; g8::desc_defaults(d); g8::gemm_phase(lds, d, e); } }
#endif
#ifndef NO_XAS
            if (kind == 11) {
                { g8::Desc d; d.A = (const bf16_t*)(ws + WS_XQ); d.Bt = (const bf16_t*)(ws + WS_XAK); d.aBS1 = d.aBS2 = d.bBS1 = d.bBS2 = 0; d.lda = 1024; d.ldb = 1024; d.K = 256; d.nM = 64; d.nN = 4; d.nB = 1; d.nB2 = 1; d.boff = 0;
                  d.aN = 256; d.bN = 256; d.bB = 256 * 1024;
                  g8::EpiXaSoft e{(bf16_t*)(ws + WS_XP), 0, 0, 1024, 1, 0.0625f * LOG2E}; g8::gemm_phase(lds, d, e); }
                { g8::Desc d; g8::EpiStore e; (void)store_job(a, 13, 0, d, e); d.aN = 256; d.bN = 256 * 256; d.bB = 1024 * 256; g8::gemm_phase(lds, d, e); } }
#endif
        }
        if (ph + 1 < a.ph_hi) {
            if (ph == 0) {
                cg::this_grid().sync();
                if (threadIdx.x == 0) (void)xb_add(&((unsigned*)(wsp(a) + WS_BAR))[XB_XCNT(xb_xcc_id())], 1u);
            } else xcd_barrier((unsigned*)(wsp(a) + WS_BAR), bst);
        }
    }
}

#ifndef MK_PH_HI
#define MK_PH_HI NPH
#endif
#ifndef MK_ONE_LAUNCH
#define MK_ONE_LAUNCH 1
#endif
extern "C" void kernel_launch(void* const* d_in, const int* in_sizes, int n_in, void* d_out, int out_size, void* d_ws, size_t ws_size, hipStream_t stream) {
    static int grid = 0;
    if (grid == 0) {
        if (n_in != 24 || out_size != T * DM || ws_size < WS_END) { fprintf(stderr, "kernel_launch: unexpected problem (n_in %d out %d ws %zu need %zu)\n", n_in, out_size, ws_size, (size_t)WS_END); grid = -1; return; }
        int dev = 0, cus = 0;
        if (hipGetDevice(&dev) != hipSuccess || hipDeviceGetAttribute(&cus, hipDeviceAttributeMultiprocessorCount, dev) != hipSuccess) { grid = -1; return; }
        if (hipFuncSetAttribute((const void*)mk_fwd, hipFuncAttributeMaxDynamicSharedMemorySize, LDS_BYTES) != hipSuccess) { fprintf(stderr, "kernel_launch: hipFuncSetAttribute failed\n"); grid = -1; return; }
        (void)hipGetLastError();
        grid = cus;
        if (grid != 256) fprintf(stderr, "kernel_launch: %d CUs (built for 256)\n", grid);
    }
    if (grid < 0) return;
    Args a{};
    for (int i = 0; i < 24; ++i) a.in[i] = d_in[i];
    a.out = (float*)d_out; a.ws = (unsigned char*)d_ws;
#if MK_ONE_LAUNCH
    a.ph_lo = 0; a.ph_hi = MK_PH_HI;
    void* args[] = {&a};
    hipError_t e = hipLaunchCooperativeKernel((const void*)mk_fwd, dim3(grid), dim3(512), args, LDS_BYTES, stream);
    if (e != hipSuccess) fprintf(stderr, "kernel_launch: cooperative launch failed: %s\n", hipGetErrorString(e));
#else
    for (int ph = 0; ph < NPH; ++ph) { a.ph_lo = ph; a.ph_hi = ph + 1; hipLaunchKernelGGL(mk_fwd, dim3(grid), dim3(512), LDS_BYTES, stream, a); }
#endif
}
```

```cpp
#include <hip/hip_runtime.h>
#include <hip/hip_cooperative_groups.h>
#include <cstdio>
#include <cstdint>
namespace cg = cooperative_groups;

#define LAS __attribute__((address_space(3)))
typedef unsigned short bf16_t;
typedef short bf16x8 __attribute__((ext_vector_type(8)));
typedef float f32x4 __attribute__((ext_vector_type(4)));
typedef float f32x2 __attribute__((ext_vector_type(2)));
typedef unsigned u32x4 __attribute__((ext_vector_type(4)));
typedef unsigned u32x2 __attribute__((ext_vector_type(2)));

constexpr int T = 16384, DM = 1024, SEQ = 2048, DFF = 2816, NLAYER = 4, PLD = 6656;
constexpr float ALPHA = 1.6817928305074292f, LOG2E = 1.4426950408889634f;
constexpr int PC_Q = 0, PC_KS = 512, PC_KW = 640, PC_GATE = 768, PC_CQ = 800, PC_CKV = 1184, PC_KR = 1440, PC_BQ = 1472, PC_BF = 1984, PC_BI = 2496, PC_BG = 3008, PC_MG = 3520;
constexpr size_t MiB = 1048576;
constexpr size_t WS_LB = 0, WS_CBIAS = 8192, WS_RSQ = 65536, WS_RSKV = 131072, WS_DEC = 262144, WS_KCMP = 1 * MiB, WS_VCMPT = 1 * MiB + 262144;
constexpr size_t WS_CNT = 819200 + 16384;
constexpr size_t WS_BAR = 819200;
constexpr size_t WS_ROPEM = 2 * MiB, WS_ROPEN = 4 * MiB, WS_W = 5 * MiB, WS_XB = 69 * MiB, WS_Z = 101 * MiB, WS_S = 165 * MiB;
constexpr size_t WS_H = WS_S, WS_PROJ = WS_S, WS_KCG = WS_S + 208 * MiB, WS_VTN = WS_S + 217 * MiB, WS_HID = WS_S + 225 * MiB, WS_MQ = WS_S + 227 * MiB;
constexpr size_t WS_KNOPE = WS_S + 251 * MiB, WS_VTM = WS_S + 267 * MiB, WS_KPE = WS_S + 283 * MiB, WS_YA = WS_S + 284 * MiB, WS_YB = WS_S + 300 * MiB, WS_YC = WS_S + 316 * MiB;
constexpr size_t WS_XAK = WS_S + 332 * MiB, WS_XAVT = WS_S + 336 * MiB, WS_MEMB = WS_S + 340 * MiB, WS_KFN = WS_S + 344 * MiB, WS_XBUF = WS_S + 352 * MiB, WS_END = WS_S + 354 * MiB;
constexpr size_t WS_XQ = WS_S, WS_XP = WS_S + 32 * MiB, WS_XO = WS_S + 64 * MiB;
constexpr int W_UP1 = 0, W_DN1 = W_UP1 + 5632 * 1024, W_UP2 = W_DN1 + 1024 * 2816, W_DN2 = W_UP2 + 5632 * 1024, W_IN = W_DN2 + 1024 * 2816;
constexpr int W_CMP = W_IN + 7168 * 1024, W_UQ = W_CMP + 2 * 256 * 2048, W_KN = W_UQ + 768 * 384, W_VM = W_KN + 512 * 256, W_BR = W_VM + 512 * 256;
constexpr int W_OUT = W_BR + 3 * 1024 * 512, W_XQ = W_OUT + 1048576, W_XO = W_XQ + 1048576, W_XK = W_XO + 1048576, W_XV = W_XK + 1048576, W_ENDE = W_XV + 1048576;
static_assert((size_t)W_ENDE * 2 <= 64 * MiB, "weights region");
constexpr int LDS_BYTES = 155648;

__device__ __forceinline__ float bf2f(bf16_t v) { return __builtin_bit_cast(float, (unsigned)v << 16); }
__device__ __forceinline__ float bflo(unsigned w) { return __builtin_bit_cast(float, w << 16); }
__device__ __forceinline__ float bfhi(unsigned w) { return __builtin_bit_cast(float, w & 0xffff0000u); }
typedef __bf16 bf16x2_t __attribute__((ext_vector_type(2)));
__device__ __forceinline__ unsigned pk2(float lo, float hi) { const f32x2 v = {lo, hi}; const bf16x2_t b = __builtin_convertvector(v, bf16x2_t); return __builtin_bit_cast(unsigned, b); }
__device__ __forceinline__ float ex2(float x) { return __builtin_amdgcn_exp2f(x); }
__device__ __forceinline__ float rcpf(float x) { return __builtin_amdgcn_rcpf(x); }
__device__ __forceinline__ float sigm(float x) { return rcpf(1.f + ex2(-x * LOG2E)); }
__device__ __forceinline__ float wave_sum(float v) {
#pragma unroll
    for (int o = 1; o < 64; o <<= 1) v += __shfl_xor(v, o);
    return v;
}

__device__ __forceinline__ int tidx() { int t = threadIdx.x; asm volatile("" : "+v"(t)); return t; }
__device__ __forceinline__ int bidx() { int t = blockIdx.x; asm volatile("" : "+s"(t)); return t; }
__device__ __forceinline__ int gdim() { int t = gridDim.x; asm volatile("" : "+s"(t)); return t; }
__device__ __forceinline__ float rmax_fq(float x) { const unsigned u = __builtin_bit_cast(unsigned, x);
    auto r = __builtin_amdgcn_permlane16_swap(u, u, false, false); float y = fmaxf(__builtin_bit_cast(float, (unsigned)r[0]), __builtin_bit_cast(float, (unsigned)r[1]));
    const unsigned v = __builtin_bit_cast(unsigned, y); auto q = __builtin_amdgcn_permlane32_swap(v, v, false, false); return fmaxf(__builtin_bit_cast(float, (unsigned)q[0]), __builtin_bit_cast(float, (unsigned)q[1])); }
__device__ __forceinline__ float rsum_fq(float x) { const unsigned u = __builtin_bit_cast(unsigned, x);
    auto r = __builtin_amdgcn_permlane16_swap(u, u, false, false); float y = __builtin_bit_cast(float, (unsigned)r[0]) + __builtin_bit_cast(float, (unsigned)r[1]);
    const unsigned v = __builtin_bit_cast(unsigned, y); auto q = __builtin_amdgcn_permlane32_swap(v, v, false, false); return __builtin_bit_cast(float, (unsigned)q[0]) + __builtin_bit_cast(float, (unsigned)q[1]); }
__device__ __forceinline__ float rsum_quad(float x) { float y = x + __builtin_bit_cast(float, __builtin_amdgcn_update_dpp(0, __builtin_bit_cast(int, x), 0xB1, 0xF, 0xF, false));
    return y + __builtin_bit_cast(float, __builtin_amdgcn_update_dpp(0, __builtin_bit_cast(int, y), 0x4E, 0xF, 0xF, false)); }
__device__ __forceinline__ f32x4 mfma16(bf16x8 a, bf16x8 b, f32x4 c) { return __builtin_amdgcn_mfma_f32_16x16x32_bf16(a, b, c, 0, 0, 0); }
__device__ __forceinline__ bf16x8 ld8(const bf16_t* p) { return *(const bf16x8*)p; }
__device__ __forceinline__ int kfrag_off(int s, int d, int ndc) { const int kb32 = s >> 5, r = s & 31, u = (r >> 2) & 1, fr = (r >> 3) * 4 + (r & 3), dc = d >> 5, fq = (d >> 3) & 3, j = d & 7;
    return (((kb32 * 2 + u) * ndc + dc) * 64 + fq * 16 + fr) * 8 + j; }
__device__ __forceinline__ int vfrag_off(int s, int dv) { const int kb32 = s >> 5, fq = (s >> 3) & 3, j = s & 7, dt = dv >> 4, fr = dv & 15; return ((kb32 * 4 + dt) * 64 + fq * 16 + fr) * 8 + j; }

namespace g8 {
constexpr int BM = 256, BK = 64, HALF = 128, HTB = HALF * BK * 2, NXCD = 8, WGM = 8;
__device__ __forceinline__ int lds_byte(int r, int c) { const int st = (r >> 4) * 2 + (c >> 5), rr = r & 15, cc = c & 31, ob = rr * 64 + cc * 2; return st * 1024 + (ob ^ (((ob >> 9) & 1) << 5)); }
__device__ __forceinline__ void stage_rc(int b, int& R, int& C) { const int st = b / 1024, sb = b % 1024, swz = sb ^ (((sb >> 9) & 1) << 5); R = (st >> 1) * 16 + swz / 64; C = (st & 1) * 32 + (swz % 64) / 2; }
__device__ __forceinline__ int perm32(int rho) { const int n = rho >> 4, i = rho & 15; return 8 * (i >> 2) + 4 * n + (i & 3); }
struct Unit { int b, pm, pn; };
struct Desc { const bf16_t* A; const bf16_t* Bt; long aBS1, aBS2, bBS1, bBS2; int lda, ldb, K, nM, nN, nB, nB2, boff; long aN, bN, bB; int bmode; };
__device__ __forceinline__ void desc_defaults(Desc& d) { d.aN = 0; d.bN = (long)BM * d.ldb; d.bB = 0; d.bmode = 0; }
__device__ __forceinline__ bool get_unit(const Desc& d, int i, Unit& u) {
    const int G = gdim(); int c = bidx() - d.boff; if (c < 0) c += G;
    const int per = d.nM * d.nN, nwg = d.bmode ? per : per * d.nB; const long L = d.bmode ? (long)c : (long)i * G + c; if (L >= nwg || (d.bmode && i >= d.nB)) return false;
    int wgid = (int)L; { const int q = nwg / NXCD, r = nwg % NXCD, xcd = wgid % NXCD, off = wgid / NXCD; wgid = (xcd < r ? xcd * (q + 1) : r * (q + 1) + (xcd - r) * q) + off; }
    u.b = d.bmode ? i : wgid / per; const int w = wgid % per;
    const int nig = WGM * d.nN, gid = w / nig, fm = gid * WGM, gsz = (d.nM - fm) < WGM ? (d.nM - fm) : WGM;
    u.pm = fm + ((w % nig) % gsz); u.pn = (w % nig) / gsz; return true;
}
template <class Epi>
__device__ __forceinline__ void gemm_phase(LAS unsigned char* lds, const Desc& g, const Epi& E) {
    const int tid = tidx(), wid = __builtin_amdgcn_readfirstlane(tid >> 6), lane = tid & 63, wr = wid >> 2, wc = wid & 3, fr = lane & 15, fq = lane >> 4;
    const int K = g.K, nt = K / BK;
    unsigned voffA[2], voffB[2];
#pragma unroll
    for (int i = 0; i < 2; ++i) { int R, C; stage_rc(tid * 16 + i * 8192, R, C); const int Rb = (R & ~31) + perm32(R & 31);
        voffA[i] = (unsigned)(R * g.lda + C) * 2u; voffB[i] = (unsigned)(Rb * g.ldb + C) * 2u; }
    const size_t kstep = (size_t)(BK * 2);
    const size_t hstepA = (size_t)HALF * g.lda * 2, hstepB = (size_t)HALF * g.ldb * 2;
    const unsigned ldsw = (unsigned)wid * 1024u;
    const int aoff = lds_byte(wr * 64 + fr, fq * 8), boff = lds_byte(wc * 32 + fr, fq * 8);
#define G8_SA(b, h) (((b) * 2 + (h)) * HTB)
#define G8_SB(b, h) ((4 + (b) * 2 + (h)) * HTB)
#define G8_STAGE(bufoff, gbase, voff) do { _Pragma("unroll") for (int _i = 0; _i < 2; ++_i) \
        __builtin_amdgcn_global_load_lds((const unsigned*)((const char*)(gbase) + (voff)[_i]), (LAS unsigned*)(lds + (bufoff) + ldsw + _i * 8192), 16, 0, 0); } while (0)
#define G8_LDA(dst, b, h) do { _Pragma("unroll") for (int m = 0; m < 4; ++m) _Pragma("unroll") for (int k = 0; k < 2; ++k) dst[m][k] = *(const LAS bf16x8*)(lds + G8_SA(b, h) + aoff + m * 2048 + k * 1024); } while (0)
#define G8_LDB(dst, b, h) do { _Pragma("unroll") for (int n = 0; n < 2; ++n) _Pragma("unroll") for (int k = 0; k < 2; ++k) dst[n][k] = *(const LAS bf16x8*)(lds + G8_SB(b, h) + boff + n * 2048 + k * 1024); } while (0)
#define G8_MMA(ai, bj, At, Bt) do { __builtin_amdgcn_s_setprio(1); _Pragma("unroll") for (int m = 0; m < 4; ++m) _Pragma("unroll") for (int n = 0; n < 2; ++n) _Pragma("unroll") for (int k = 0; k < 2; ++k) \
        acc[ai][bj][m][n] = __builtin_amdgcn_mfma_f32_16x16x32_bf16(Bt[n][k], At[m][k], acc[ai][bj][m][n], 0, 0, 0); __builtin_amdgcn_s_setprio(0); } while (0)
#define G8_WAIT_V(n) asm volatile("s_waitcnt vmcnt(" #n ")" ::: "memory")
#define G8_WAIT_L(n) asm volatile("s_waitcnt lgkmcnt(" #n ")" ::: "memory")
#define G8_BAR __builtin_amdgcn_s_barrier()
#define G8_SCHED __builtin_amdgcn_sched_barrier(0)
#define G8_UA(u) ((const char*)g.A + 2 * ((size_t)((u).b / g.nB2) * g.aBS1 + (size_t)((u).b % g.nB2) * g.aBS2 + (size_t)(u).pm * BM * g.lda + (size_t)(u).pn * g.aN))
#define G8_UB(u) ((const char*)g.Bt + 2 * ((size_t)((u).b / g.nB2) * g.bBS1 + (size_t)((u).b % g.nB2) * g.bBS2 + (size_t)(u).pn * g.bN + (size_t)((u).pm >> 3) * g.bB))
    Unit cur, nxt; int ui = 0;
    if (!get_unit(g, 0, cur)) return;
    f32x4 acc[2][2][4][2];
#pragma unroll
    for (int a = 0; a < 2; ++a)
#pragma unroll
        for (int b = 0; b < 2; ++b)
#pragma unroll
            for (int m = 0; m < 4; ++m)
#pragma unroll
                for (int n = 0; n < 2; ++n) acc[a][b][m][n] = (f32x4){0.f, 0.f, 0.f, 0.f};
    bf16x8 At[4][2], B0[2][2], B1[2][2];
    const char* cA = G8_UA(cur); const char* cB = G8_UB(cur);
    G8_STAGE(G8_SB(0, 0), cB, voffB); G8_STAGE(G8_SB(0, 1), cB + hstepB, voffB); G8_STAGE(G8_SA(0, 0), cA, voffA); G8_STAGE(G8_SA(0, 1), cA + hstepA, voffA);
    if (wr == 1) G8_BAR;
    G8_WAIT_V(2); G8_BAR;
    G8_STAGE(G8_SB(1, 0), cB + kstep, voffB); G8_STAGE(G8_SA(1, 0), cA + kstep, voffA); G8_STAGE(G8_SB(1, 1), cB + hstepB + kstep, voffB);
    G8_WAIT_V(6); G8_BAR;
    for (;;) {
        const bool has_next = get_unit(g, ui + 1, nxt);
        const char* nA = has_next ? G8_UA(nxt) : cA; const char* nB = has_next ? G8_UB(nxt) : cB;
        for (int t = 0; t < nt; t += 2) {
            const bool last = (t == nt - 2);
            const char* a1 = cA + (size_t)(t + 1) * kstep;
            const char* a2 = last ? nA : cA + (size_t)(t + 2) * kstep; const char* b2 = last ? nB : cB + (size_t)(t + 2) * kstep;
            const char* a3 = a2 + kstep; const char* b3 = b2 + kstep;
            G8_LDB(B0, 0, 0); G8_LDB(B1, 0, 1); G8_SCHED; G8_LDA(At, 0, 0); G8_STAGE(G8_SA(1, 1), a1 + hstepA, voffA);
            G8_WAIT_V(8); G8_WAIT_L(0); G8_BAR; G8_MMA(0, 0, At, B0); G8_MMA(0, 1, At, B1); G8_BAR; G8_SCHED;
            G8_LDA(At, 0, 1); G8_STAGE(G8_SB(0, 0), b2, voffB); G8_STAGE(G8_SB(0, 1), b2 + hstepB, voffB); G8_STAGE(G8_SA(0, 0), a2, voffA);
            G8_WAIT_V(8); G8_WAIT_L(0); G8_BAR; G8_MMA(1, 0, At, B0); G8_MMA(1, 1, At, B1); G8_BAR; G8_SCHED;
            G8_LDB(B0, 1, 0); G8_LDB(B1, 1, 1); G8_SCHED; G8_LDA(At, 1, 0); G8_STAGE(G8_SA(0, 1), a2 + hstepA, voffA);
            G8_WAIT_V(8); G8_WAIT_L(0); G8_BAR; G8_MMA(0, 0, At, B0); G8_MMA(0, 1, At, B1); G8_BAR; G8_SCHED;
            G8_LDA(At, 1, 1); G8_STAGE(G8_SB(1, 0), b3, voffB); G8_STAGE(G8_SB(1, 1), b3 + hstepB, voffB); G8_STAGE(G8_SA(1, 0), a3, voffA);
            G8_WAIT_V(8); G8_WAIT_L(0); G8_BAR; G8_MMA(1, 0, At, B0); G8_MMA(1, 1, At, B1); G8_BAR; G8_SCHED;
        }
        if (wr == 0) G8_BAR;
        if constexpr (!Epi::AFTER_DRAIN) { E(acc, cur, wr, wc, fr, fq); }
        if (!has_next) break;
        if (!g.bmode) {
#pragma unroll
        for (int a = 0; a < 2; ++a)
#pragma unroll
            for (int b = 0; b < 2; ++b)
#pragma unroll
                for (int m = 0; m < 4; ++m)
#pragma unroll
                    for (int n = 0; n < 2; ++n) acc[a][b][m][n] = (f32x4){0.f, 0.f, 0.f, 0.f};
        }
        cur = nxt; cA = nA; cB = nB; ++ui;
        if (wr == 1) G8_BAR;
    }
    G8_WAIT_V(0);
    G8_BAR;
    if constexpr (Epi::AFTER_DRAIN) { E.fused(acc, cur, wr, wc, fr, fq, lds, wid, lane); }
}

struct EpiSwiglu { static constexpr bool AFTER_DRAIN = false; bf16_t* H;
    __device__ __forceinline__ void operator()(const f32x4 (&acc)[2][2][4][2], const Unit& u, int wr, int wc, int fr, int fq) const {
        const int row0 = u.pm * BM + wr * 64 + fr, hc0 = u.pn * 128 + wc * 16 + fq * 4;
#pragma unroll
        for (int ai = 0; ai < 2; ++ai)
#pragma unroll
            for (int m = 0; m < 4; ++m) { bf16_t* rp = H + (size_t)(row0 + ai * HALF + m * 16) * DFF + hc0;
#pragma unroll
                for (int bj = 0; bj < 2; ++bj) { const f32x4 a = acc[ai][bj][m][0], b = acc[ai][bj][m][1]; float h[4];
#pragma unroll
                    for (int j = 0; j < 4; ++j) h[j] = a[j] * sigm(a[j]) * b[j];
                    u32x2 w; w.x = pk2(h[0], h[1]); w.y = pk2(h[2], h[3]); *(u32x2*)(rp + bj * 64) = w; } }
    }
};
struct EpiResid { static constexpr bool AFTER_DRAIN = false; const float* X; float* Z; float s;
    __device__ __forceinline__ void operator()(const f32x4 (&acc)[2][2][4][2], const Unit& u, int wr, int wc, int fr, int fq) const {
        const int row0 = u.pm * BM + wr * 64 + fr, c0 = u.pn * BM + wc * 32 + fq * 8;
#pragma unroll
        for (int ai = 0; ai < 2; ++ai)
#pragma unroll
            for (int m = 0; m < 4; ++m) { const size_t ro = (size_t)(row0 + ai * HALF + m * 16) * DM + c0;
#pragma unroll
                for (int bj = 0; bj < 2; ++bj)
#pragma unroll
                    for (int n = 0; n < 2; ++n) { const f32x4 x = *(const f32x4*)(X + ro + bj * HALF + n * 4); *(f32x4*)(Z + ro + bj * HALF + n * 4) = x * ALPHA + acc[ai][bj][m][n] * s; } }
    }
};
struct EpiLn { static constexpr bool AFTER_DRAIN = false; const float* XI; float* XF; bf16_t* XB; const float* g; const float* bt; float s; unsigned long long* xbuf; unsigned* cnt; unsigned target;
    __device__ __forceinline__ void operator()(f32x4 (&acc)[2][2][4][2], const Unit& u, int wr, int wc, int fr, int fq) const {
        const int row0 = u.pm * BM + wr * 64 + fr, c0 = u.pn * BM + wc * 32 + fq * 8;
        unsigned long long* xb0 = xbuf + ((size_t)u.pm * 256 + wr * 64 + fr) * 16;
#pragma unroll
        for (int ai = 0; ai < 2; ++ai)
#pragma unroll
            for (int m = 0; m < 4; ++m) { const size_t ro = (size_t)(row0 + ai * HALF + m * 16) * DM + c0; float s1 = 0.f, s2 = 0.f;
#pragma unroll
                for (int bj = 0; bj < 2; ++bj)
#pragma unroll
                    for (int n = 0; n < 2; ++n) { const f32x4 x = *(const f32x4*)(XI + ro + bj * HALF + n * 4); const f32x4 z = x * ALPHA + acc[ai][bj][m][n] * s; acc[ai][bj][m][n] = z;
                        s1 += (z[0] + z[1]) + (z[2] + z[3]); s2 += (z[0] * z[0] + z[1] * z[1]) + (z[2] * z[2] + z[3] * z[3]); }
                s1 = rsum_fq(s1); s2 = rsum_fq(s2);
                if (fq == 0) { const unsigned long long bits = ((unsigned long long)__builtin_bit_cast(unsigned, s2) << 32) | (unsigned long long)__builtin_bit_cast(unsigned, s1);
                    __hip_atomic_store(xb0 + (size_t)(ai * HALF + m * 16) * 16 + u.pn * 4 + wc, bits, __ATOMIC_RELAXED, __HIP_MEMORY_SCOPE_AGENT); }
                if (m == 3) __builtin_amdgcn_sched_barrier(0); }
        asm volatile("s_waitcnt vmcnt(0)" ::: "memory");
        unsigned* cw = cnt + (u.pm * 2 + wr) * 64;
        if (fr == 0 && fq == 0) (void)__hip_atomic_fetch_add(cw, 1u, __ATOMIC_RELAXED, __HIP_MEMORY_SCOPE_AGENT);
        for (unsigned sp = 0; sp < (1u << 22); ++sp) { if (__hip_atomic_load(cw, __ATOMIC_RELAXED, __HIP_MEMORY_SCOPE_AGENT) >= target) break; __builtin_amdgcn_s_sleep(2); }
        asm volatile("s_waitcnt vmcnt(0)" ::: "memory");
#pragma unroll
        for (int ai = 0; ai < 2; ++ai)
#pragma unroll
            for (int m = 0; m < 4; ++m) { const unsigned long long* rp = xb0 + (size_t)(ai * HALF + m * 16) * 16 + fq * 4; float s1 = 0.f, s2 = 0.f;
#pragma unroll
                for (int k = 0; k < 4; ++k) { const unsigned long long bits = __hip_atomic_load(rp + k, __ATOMIC_RELAXED, __HIP_MEMORY_SCOPE_AGENT);
                    s1 += __builtin_bit_cast(float, (unsigned)(bits & 0xffffffffull)); s2 += __builtin_bit_cast(float, (unsigned)(bits >> 32)); }
                s1 = rsum_fq(s1); s2 = rsum_fq(s2);
                const float mean = s1 * (1.f / 1024.f), rstd = rsqrtf(fmaxf(s2 * (1.f / 1024.f) - mean * mean, 0.f) + 1e-5f);
                const size_t ro = (size_t)(row0 + ai * HALF + m * 16) * DM + c0;
#pragma unroll
                for (int bj = 0; bj < 2; ++bj) { const int c = c0 + bj * HALF; const f32x4 g0 = *(const f32x4*)(g + c), g1 = *(const f32x4*)(g + c + 4), b0 = *(const f32x4*)(bt + c), b1 = *(const f32x4*)(bt + c + 4);
                    const f32x4 y0 = (acc[ai][bj][m][0] - mean) * rstd * g0 + b0, y1 = (acc[ai][bj][m][1] - mean) * rstd * g1 + b1;
                    *(f32x4*)(XF + ro + bj * HALF) = y0; *(f32x4*)(XF + ro + bj * HALF + 4) = y1;
                    u32x4 w; w.x = pk2(y0[0], y0[1]); w.y = pk2(y0[2], y0[3]); w.z = pk2(y1[0], y1[1]); w.w = pk2(y1[2], y1[3]); *(u32x4*)(XB + ro + bj * HALF) = w; }
                if (m == 3) __builtin_amdgcn_sched_barrier(0); }
    }
};
struct EpiStore { static constexpr bool AFTER_DRAIN = false;
    bf16_t* O; long oBS1, oBS2; int ldc, split_shift; long split_stride; const float* rowscale; const float* colscale; const float* bias; int act, nB2, lay;
    __device__ __forceinline__ void operator()(const f32x4 (&acc)[2][2][4][2], const Unit& u, int wr, int wc, int fr, int fq) const {
        bf16_t* base = O + (size_t)(u.b / nB2) * oBS1 + (size_t)(u.b % nB2) * oBS2;
        const int row0 = u.pm * BM + wr * 64 + fr, c0 = u.pn * BM + wc * 32 + fq * 8;
#pragma unroll
        for (int ai = 0; ai < 2; ++ai)
#pragma unroll
            for (int m = 0; m < 4; ++m) { const int row = row0 + ai * HALF + m * 16; const float rs = rowscale ? rowscale[row] : 1.f;
#pragma unroll
                for (int bj = 0; bj < 2; ++bj) { const int c = c0 + bj * HALF; float v[8];
#pragma unroll
                    for (int j = 0; j < 4; ++j) { v[j] = acc[ai][bj][m][0][j]; v[4 + j] = acc[ai][bj][m][1][j]; }
                    if (bias) {
#pragma unroll
                        for (int j = 0; j < 8; ++j) v[j] += bias[c + j]; }
                    if (act) {
#pragma unroll
                        for (int j = 0; j < 8; ++j) { const float x = v[j], uu = 0.7978845608028654f * (x + 0.044715f * x * x * x); v[j] = x * sigm(2.f * uu); } }
#ifdef MK_SAN3
                    if (act) {
#pragma unroll
                        for (int j = 0; j < 8; ++j) if (!(fabsf(v[j]) < 1.0e6f)) v[j] = 0.f; }
#endif
                    if (colscale) {
#pragma unroll
                        for (int j = 0; j < 8; ++j) v[j] *= colscale[c + j]; }
                    u32x4 w; w.x = pk2(v[0] * rs, v[1] * rs); w.y = pk2(v[2] * rs, v[3] * rs); w.z = pk2(v[4] * rs, v[5] * rs); w.w = pk2(v[6] * rs, v[7] * rs);
                    const size_t co = split_shift ? (size_t)(c >> split_shift) * split_stride + (c & ((1 << split_shift) - 1)) : (size_t)c;
                    bf16_t* dst = base + (size_t)row * ldc + co;
                    if (lay == 1) dst = base + (size_t)((row >> 6) * 8 + (c >> 11)) * 131072 + vfrag_off(c & 2047, row & 63);
                    else if (lay == 2) dst = base + (size_t)((c >> 6) * 8 + (row >> 11)) * 131072 + kfrag_off(row & 2047, c & 63, 2);
                    *(u32x4*)dst = w; } }
    }
};
struct EpiMerge { static constexpr bool AFTER_DRAIN = false; const bf16_t* P; float* Z; bf16_t* MX; int unused_;
    __device__ __forceinline__ void operator()(f32x4 (&acc)[2][2][4][2], const Unit& u, int wr, int wc, int fr, int fq) const {
        const int row0 = u.pm * BM + wr * 64 + fr, c0 = u.pn * BM + wc * 32 + fq * 8; const int i = u.b;
#pragma unroll
        for (int ai = 0; ai < 2; ++ai)
#pragma unroll
            for (int m = 0; m < 4; ++m) { const int row = row0 + ai * HALF + m * 16;
#pragma unroll
                for (int bj = 0; bj < 2; ++bj) { const int c = c0 + bj * HALF;
                    const u32x4 gw = *(const u32x4*)(P + (size_t)row * PLD + PC_MG + i * DM + c);
                    float gi[8] = {sigm(bflo(gw.x)), sigm(bfhi(gw.x)), sigm(bflo(gw.y)), sigm(bfhi(gw.y)), sigm(bflo(gw.z)), sigm(bfhi(gw.z)), sigm(bflo(gw.w)), sigm(bfhi(gw.w))};
#pragma unroll
                    for (int j = 0; j < 8; ++j) gi[j] = fmaxf(gi[j], 1e-20f);
                    if (i < 2) { const u32x4 nw = *(const u32x4*)(P + (size_t)row * PLD + PC_MG + (i + 1) * DM + c);
                        const float gn[8] = {sigm(bflo(nw.x)), sigm(bfhi(nw.x)), sigm(bflo(nw.y)), sigm(bfhi(nw.y)), sigm(bflo(nw.z)), sigm(bfhi(nw.z)), sigm(bflo(nw.w)), sigm(bfhi(nw.w))};
#pragma unroll
                        for (int j = 0; j < 4; ++j) { acc[ai][bj][m][0][j] = acc[ai][bj][m][0][j] * (gi[j] / fmaxf(gn[j], 1e-20f)); acc[ai][bj][m][1][j] = acc[ai][bj][m][1][j] * (gi[4 + j] / fmaxf(gn[4 + j], 1e-20f)); } }
                    else { u32x4 w; w.x = pk2(acc[ai][bj][m][0][0] * gi[0], acc[ai][bj][m][0][1] * gi[1]); w.y = pk2(acc[ai][bj][m][0][2] * gi[2], acc[ai][bj][m][0][3] * gi[3]);
                        w.z = pk2(acc[ai][bj][m][1][0] * gi[4], acc[ai][bj][m][1][1] * gi[5]); w.w = pk2(acc[ai][bj][m][1][2] * gi[6], acc[ai][bj][m][1][3] * gi[7]);
                        *(u32x4*)(MX + (size_t)row * DM + c) = w; } } }
    }
};
struct EpiMlaQ { static constexpr bool AFTER_DRAIN = false; bf16_t* O; const float* rstd; const f32x2* rope;
    __device__ __forceinline__ void operator()(const f32x4 (&acc)[2][2][4][2], const Unit& u, int wr, int wc, int fr, int fq) const {
        const int row0 = u.pm * BM + wr * 64 + fr, c0 = u.pn * BM + wc * 32 + fq * 8;
        const float qs = 0.10206207261596577f * LOG2E;
#pragma unroll
        for (int ai = 0; ai < 2; ++ai)
#pragma unroll
            for (int m = 0; m < 4; ++m) { const int row = row0 + ai * HALF + m * 16; const float rs = rstd[row];
#pragma unroll
                for (int bj = 0; bj < 2; ++bj) { const int c = c0 + bj * HALF; const bool pe = (((u.pn * BM + bj * HALF + wc * 32) >> 5) % 3) == 2;
                    float v[8];
#pragma unroll
                    for (int j = 0; j < 4; ++j) { v[j] = acc[ai][bj][m][0][j] * rs; v[4 + j] = acc[ai][bj][m][1][j] * rs; }
                    if (pe) {
#pragma unroll
                        for (int j = 0; j < 8; ++j) { const float o = __shfl_xor(v[j], 32); const f32x2 cs = rope[(size_t)row * 16 + ((fq & 1) * 8 + j)];
                            v[j] = (fq < 2) ? (v[j] * cs.x - o * cs.y) : (v[j] * cs.x + o * cs.y); } }
                    u32x4 w; w.x = pk2(v[0] * qs, v[1] * qs); w.y = pk2(v[2] * qs, v[3] * qs); w.z = pk2(v[4] * qs, v[5] * qs); w.w = pk2(v[6] * qs, v[7] * qs);
                    *(u32x4*)(O + (size_t)row * 768 + c) = w; } }
    }
};
struct EpiXaSoft { static constexpr bool AFTER_DRAIN = true; bf16_t* O; long oBS1, oBS2; int ldc, nB2; float sc;
    __device__ __forceinline__ void fused(const f32x4 (&acc)[2][2][4][2], const Unit& u, int wr, int wc, int fr, int fq, LAS unsigned char* lds, int wid, int lane) const {
        LAS float* red = (LAS float*)lds;
        LAS float* red2 = red + 1024;
#pragma unroll
        for (int ai = 0; ai < 2; ++ai)
#pragma unroll
            for (int m = 0; m < 4; ++m) { float v = -3.0e38f;
#pragma unroll
                for (int bj = 0; bj < 2; ++bj)
#pragma unroll
                    for (int n = 0; n < 2; ++n)
#pragma unroll
                        for (int j = 0; j < 4; ++j) v = fmaxf(v, acc[ai][bj][m][n][j]);
                v = rmax_fq(v);
                if (fq == 0) red[(ai * HALF + wr * 64 + m * 16 + fr) * 4 + wc] = v; }
        __syncthreads();
#pragma unroll
        for (int ai = 0; ai < 2; ++ai)
#pragma unroll
            for (int m = 0; m < 4; ++m) { const int rr = ai * HALF + wr * 64 + m * 16 + fr; const f32x4 q = *(const LAS f32x4*)(red + rr * 4);
                const float mm = fmaxf(fmaxf(q[0], q[1]), fmaxf(q[2], q[3])); float s = 0.f;
#pragma unroll
                for (int bj = 0; bj < 2; ++bj)
#pragma unroll
                    for (int n = 0; n < 2; ++n)
#pragma unroll
                        for (int j = 0; j < 4; ++j) s += ex2((acc[ai][bj][m][n][j] - mm) * sc);
                s = rsum_fq(s);
                if (fq == 0) red2[rr * 4 + wc] = s; }
        __syncthreads();
        bf16_t* base = O + (size_t)(u.b / nB2) * oBS1 + (size_t)(u.b % nB2) * oBS2;
#pragma unroll
        for (int ai = 0; ai < 2; ++ai)
#pragma unroll
            for (int m = 0; m < 4; ++m) { const int rr = ai * HALF + wr * 64 + m * 16 + fr; const f32x4 q = *(const LAS f32x4*)(red + rr * 4), q2 = *(const LAS f32x4*)(red2 + rr * 4);
                const float mm = fmaxf(fmaxf(q[0], q[1]), fmaxf(q[2], q[3])); const float inv = 1.f / ((q2[0] + q2[1]) + (q2[2] + q2[3]));
#pragma unroll
                for (int bj = 0; bj < 2; ++bj) { const int c = bj * HALF + wc * 32 + fq * 8; float p[8];
#pragma unroll
                    for (int j = 0; j < 4; ++j) { p[j] = ex2((acc[ai][bj][m][0][j] - mm) * sc) * inv; p[4 + j] = ex2((acc[ai][bj][m][1][j] - mm) * sc) * inv; }
                    u32x4 w; w.x = pk2(p[0], p[1]); w.y = pk2(p[2], p[3]); w.z = pk2(p[4], p[5]); w.w = pk2(p[6], p[7]);
                    *(u32x4*)(base + (size_t)(u.pm * BM + rr) * ldc + u.pn * BM + c) = w; } }
        asm volatile("s_waitcnt vmcnt(0)" ::: "memory");
        __syncthreads();
    }
};
}

struct FAS { f32x4 o[4]; float m, l; };
__device__ __forceinline__ void fas_init(FAS& s) {
#pragma unroll
    for (int d = 0; d < 4; ++d) s.o[d] = (f32x4){0.f, 0.f, 0.f, 0.f};
    s.m = -1.0e30f; s.l = 0.f;
}
template <int NDC> struct FAFrag { bf16x8 kf[2][NDC], vf[4]; };
template <int NDC>
__device__ __forceinline__ void fa_load(FAFrag<NDC>& f, const bf16_t* const (&kb)[NDC], const int (&kcs)[NDC], const bf16_t* vt, int key0, int lane) {
    const int kb32 = key0 >> 5;
#pragma unroll
    for (int u = 0; u < 2; ++u)
#pragma unroll
        for (int dc = 0; dc < NDC; ++dc) f.kf[u][dc] = ld8(kb[dc] + (size_t)(kb32 * 2 + u) * kcs[dc] + lane * 8);
#pragma unroll
    for (int dt = 0; dt < 4; ++dt) f.vf[dt] = ld8(vt + (size_t)(kb32 * 4 + dt) * 512 + lane * 8);
}
template <int NCT, int NDC, class MaskF>
__device__ __forceinline__ void fa_compute(FAS (&st)[NCT], const bf16x8 (&qf)[NCT][NDC], const FAFrag<NDC>& f, int key0, float sscale, bool domask, const MaskF& valid, int fr, int fq) {
#pragma unroll
    for (int ct = 0; ct < NCT; ++ct) {
        f32x4 s[2];
#pragma unroll
        for (int u = 0; u < 2; ++u) { s[u] = (f32x4){0.f, 0.f, 0.f, 0.f};
#pragma unroll
            for (int dc = 0; dc < NDC; ++dc) s[u] = mfma16(f.kf[u][dc], qf[ct][dc], s[u]); }
        float sv[8]; bool ok[8];
#pragma unroll
        for (int e = 0; e < 8; ++e) { sv[e] = s[e >> 2][e & 3] * sscale; ok[e] = domask ? valid(ct, key0 + fq * 8 + e) : true; }
        float mx = -1.0e30f;
#pragma unroll
        for (int e = 0; e < 8; ++e) mx = fmaxf(mx, ok[e] ? sv[e] : -1.0e30f);
        mx = rmax_fq(mx);
        const float mn = fmaxf(st[ct].m, mx), alpha = ex2(st[ct].m - mn);
        float p[8], ls = 0.f;
#pragma unroll
        for (int e = 0; e < 8; ++e) { p[e] = ok[e] ? ex2(sv[e] - mn) : 0.f; ls += p[e]; }
        ls = rsum_fq(ls);
        st[ct].l = st[ct].l * alpha + ls; st[ct].m = mn;
        u32x4 pw; pw.x = pk2(p[0], p[1]); pw.y = pk2(p[2], p[3]); pw.z = pk2(p[4], p[5]); pw.w = pk2(p[6], p[7]);
        const bf16x8 pb = __builtin_bit_cast(bf16x8, pw);
#pragma unroll
        for (int dt = 0; dt < 4; ++dt) { st[ct].o[dt] = st[ct].o[dt] * alpha; st[ct].o[dt] = mfma16(f.vf[dt], pb, st[ct].o[dt]); }
    }
}
template <int NCT, int NDC, class MaskF>
__device__ __forceinline__ void fa_step(FAS (&st)[NCT], const bf16x8 (&qf)[NCT][NDC], const bf16_t* const (&kb)[NDC], const int (&kcs)[NDC], const bf16_t* vt,
                                        int key0, float sscale, bool domask, const MaskF& valid, int lane) {
    FAFrag<NDC> f; fa_load<NDC>(f, kb, kcs, vt, key0, lane); fa_compute<NCT, NDC>(st, qf, f, key0, sscale, domask, valid, lane & 15, lane >> 4);
}
template <int NCT, int NDC, class MaskF>
__device__ __forceinline__ void fa_step2(FAS (&st)[NCT], const bf16x8 (&qf)[NCT][NDC], const bf16_t* const (&kb)[NDC], const int (&kcs)[NDC], const bf16_t* vt,
                                         int key0, float sscale, bool domask0, bool domask1, const MaskF& valid, int lane) {
    FAFrag<NDC> f0, f1; fa_load<NDC>(f0, kb, kcs, vt, key0, lane); fa_load<NDC>(f1, kb, kcs, vt, key0 + 32, lane);
    fa_compute<NCT, NDC>(st, qf, f0, key0, sscale, domask0, valid, lane & 15, lane >> 4); fa_compute<NCT, NDC>(st, qf, f1, key0 + 32, sscale, domask1, valid, lane & 15, lane >> 4);
}

#define XB_TMO      128
#define XB_XCNT(j)  (256  + 64 * (j))
#define XB_XSUB(j)  (1280 + 64 * (j))
#define XB_XGEN(j)  (2304 + 64 * (j))
#define XB_TOP      3328
#define XB_TOPGEN   3392
#define XCD_BAR_WORDS 3456
#define XB_SPIN_CAP (1u << 20)
__device__ __forceinline__ unsigned xb_ld(unsigned* p)              { return __hip_atomic_load(p, __ATOMIC_RELAXED, __HIP_MEMORY_SCOPE_AGENT); }
__device__ __forceinline__ unsigned xb_add(unsigned* p, unsigned v) { return __hip_atomic_fetch_add(p, v, __ATOMIC_RELAXED, __HIP_MEMORY_SCOPE_AGENT); }
__device__ __forceinline__ unsigned xb_xcc_id() { return (unsigned)__builtin_amdgcn_s_getreg((3 << 11) | 20) & 0xFu; }
#define XB_SPIN(cond, bar) do { unsigned _sp = 0; while (cond) { __builtin_amdgcn_s_sleep(1); \
    if ((++_sp & 255u) == 0u) { if (xb_ld(&(bar)[XB_TMO])) break; if (_sp > XB_SPIN_CAP) { atomicAdd(&(bar)[XB_TMO], 1u); break; } } } } while (0)
__device__ __forceinline__ void xcd_barrier_complete(unsigned* bar, unsigned x, unsigned& nloc, unsigned& nx) {
    const unsigned G = gridDim.x;
    unsigned sum, cnt, mine, sp = 0u;
    for (;;) {
        sum = 0u; cnt = 0u; mine = 0u;
#pragma unroll
        for (unsigned j = 0; j < 16; ++j) { const unsigned c = xb_ld(&bar[XB_XCNT(j)]); sum += c; cnt += (c > 0u) ? 1u : 0u; mine = (j == x) ? c : mine; }
        if (sum == G) break;
        __builtin_amdgcn_s_sleep(1);
        if ((++sp & 255u) == 0u) { if (xb_ld(&bar[XB_TMO])) break; if (sp > XB_SPIN_CAP) { atomicAdd(&bar[XB_TMO], 1u); break; } }
    }
    nloc = mine > 0u ? mine : 1u; nx = cnt > 0u ? cnt : 1u;
}
__device__ __forceinline__ void xcd_barrier(unsigned* bar, volatile LAS unsigned* st) {
    asm volatile("s_waitcnt vmcnt(0)" ::: "memory");
    __syncthreads();
    if (threadIdx.x == 0) {
        const unsigned x = xb_xcc_id();
        __builtin_amdgcn_s_waitcnt(0);
        unsigned nloc = st[0], nx = st[1];
        if (nloc == 0u) { xcd_barrier_complete(bar, x, nloc, nx); st[0] = nloc; st[1] = nx; }
        const unsigned old = xb_add(&bar[XB_XSUB(x)], 1u);
        const unsigned gen = old / nloc;
        if (old + 1u == (gen + 1u) * nloc) {
            __builtin_amdgcn_fence(__ATOMIC_RELEASE, "agent");
            asm volatile("s_waitcnt vmcnt(0)" ::: "memory");
            const unsigned og = xb_add(&bar[XB_TOP], 1u);
            const unsigned tg = og / nx;
            if (og + 1u == (tg + 1u) * nx) xb_add(&bar[XB_TOPGEN], 1u);
            else XB_SPIN(xb_ld(&bar[XB_TOPGEN]) == tg, bar);
            __builtin_amdgcn_fence(__ATOMIC_ACQUIRE, "agent");
            xb_add(&bar[XB_XGEN(x)], 1u);
            asm volatile("s_waitcnt vmcnt(0)" ::: "memory");
        } else {
            XB_SPIN(xb_ld(&bar[XB_XGEN(x)]) == gen, bar);
            __builtin_amdgcn_fence(__ATOMIC_ACQUIRE, "agent");
            asm volatile("s_waitcnt vmcnt(0)" ::: "memory");
        }
    }
    __syncthreads();
}

struct Args { const void* in[24]; float* out; unsigned char* ws; int ph_lo, ph_hi; };
__device__ __forceinline__ unsigned char* wsp(const Args& a) { unsigned char* p = a.ws; asm volatile("" : "+s"(p)); return p; }
__device__ __forceinline__ const void* inp(const Args& a, int i) { const void* p = a.in[i]; asm volatile("" : "+s"(p)); return p; }
__device__ __forceinline__ float* outp(const Args& a) { float* p = a.out; asm volatile("" : "+s"(p)); return p; }

__device__ __forceinline__ void phase_init(const Args& a) {
    unsigned char* ws = wsp(a);
    const int gtid = bidx() * 512 + tidx(), GT = gdim() * 512;
    const int* pos = (const int*)inp(a, 2);
    f32x2* ropeM = (f32x2*)(ws + WS_ROPEM); f32x2* ropeN = (f32x2*)(ws + WS_ROPEN);
    for (int idx = gtid; idx < T * 16; idx += GT) { const int tok = idx >> 4, i = idx & 15; const float p = (float)pos[tok];
        { const float inv = powf(500000.0f, -(float)i / 16.0f), ang = p * inv; ropeM[idx] = (f32x2){cosf(ang), sinf(ang)}; }
        if (i < 8) { const float inv = powf(500000.0f, -(float)i / 8.0f), ang = p * inv; ropeN[tok * 8 + i] = (f32x2){cosf(ang), sinf(ang)}; } }
    if (gtid < 512) { const float* lg = (const float*)inp(a, 12); float* lb = (float*)(ws + WS_LB);
        const float l0 = lg[gtid], l1 = lg[512 + gtid], l2 = lg[1024 + gtid], l3 = lg[1536 + gtid], m = fmaxf(fmaxf(l0, l1), fmaxf(l2, l3));
        const float e0 = expf(l0 - m), e1 = expf(l1 - m), e2 = expf(l2 - m), e3 = expf(l3 - m), inv = 1.f / (e0 + e1 + e2 + e3);
        const float p0 = e0 * inv, p1 = e1 * inv, p2 = e2 * inv, p3 = e3 * inv; const float c1 = p0 + p1, c2 = c1 + p2, c3 = c2 + p3;
        lb[gtid] = 0.f; lb[512 + gtid] = c1 - p0; lb[1024 + gtid] = c2 - p0; lb[1536 + gtid] = c3 - p0; }
    { const f32x4* x = (const f32x4*)inp(a, 0); f32x4* xf = (f32x4*)outp(a); u32x2* xb = (u32x2*)(ws + WS_XB);
      for (int i = gtid; i < T * DM / 4; i += GT) { const f32x4 v = x[i]; u32x2 w; w.x = pk2(v[0], v[1]); w.y = pk2(v[2], v[3]); xb[i] = w; } (void)xf; }
    { const f32x4* x = (const f32x4*)inp(a, 1); u32x2* mb = (u32x2*)(ws + WS_MEMB);
      for (int i = gtid; i < 2048 * DM / 4; i += GT) { const f32x4 v = x[i]; u32x2 w; w.x = pk2(v[0], v[1]); w.y = pk2(v[2], v[3]); mb[i] = w; } }
    { unsigned* z = (unsigned*)(ws + WS_KCG + 8 * MiB); for (int i = gtid; i < 16384; i += GT) z[i] = 0u; }
    if (bidx() == 0) { unsigned* bz = (unsigned*)(ws + WS_BAR); for (int i = tidx(); i < 12288 + 256; i += 512) bz[i] = 0u; }
}

constexpr int NSEG = 36;
__device__ const int SEGT[NSEG][10] = {
    {5, 2 * 1024 * 2816, 0, 2816, 0, 2816, 1024, W_UP1, 1, -1}, {6, 2 * 1024 * 2816, 0, 2816, 0, 2816, 1024, W_UP1, 2, -1},
    {5, 2 * 1024 * 2816, 1024 * 2816, 2816, 0, 2816, 1024, W_UP2, 1, -1}, {6, 2 * 1024 * 2816, 1024 * 2816, 2816, 0, 2816, 1024, W_UP2, 2, -1},
    {7, 2 * 2816 * 1024, 0, 1024, 0, 1024, 2816, W_DN1, 0, -1}, {7, 2 * 2816 * 1024, 2816 * 1024, 1024, 0, 1024, 2816, W_DN2, 0, -1},
    {8, 1024 * 7096, 0, 7096, 0, 512, 1024, W_IN + 0 * 1024, 0, -1},
    {8, 1024 * 7096, 0, 7096, 512, 128, 1024, W_IN + 6656 * 1024, 0, -1},
    {8, 1024 * 7096, 0, 7096, 640, 128, 1024, W_IN + 6784 * 1024, 0, -1},
    {8, 1024 * 7096, 0, 7096, 768, 128, 1024, W_IN + 512 * 1024, 0, -1},
    {8, 1024 * 7096, 0, 7096, 896, 128, 1024, W_IN + 6912 * 1024, 0, -1},
    {8, 1024 * 7096, 0, 7096, 1024, 128, 1024, W_IN + 640 * 1024, 0, -1},
    {8, 1024 * 7096, 0, 7096, 1152, 128, 1024, W_IN + 7040 * 1024, 0, -1},
    {8, 1024 * 7096, 0, 7096, 1280, 24, 1024, W_IN + 768 * 1024, 0, -1},
    {8, 1024 * 7096, 0, 7096, 1304, 512, 1024, W_IN + 1472 * 1024, 0, -1},
    {8, 1024 * 7096, 0, 7096, 1816, 512, 1024, W_IN + 1984 * 1024, 0, -1},
    {8, 1024 * 7096, 0, 7096, 2328, 512, 1024, W_IN + 2496 * 1024, 0, -1},
    {8, 1024 * 7096, 0, 7096, 2840, 512, 1024, W_IN + 3008 * 1024, 0, -1},
    {8, 1024 * 7096, 0, 7096, 3352, 384, 1024, W_IN + 800 * 1024, 0, -1},
    {8, 1024 * 7096, 0, 7096, 3736, 256, 1024, W_IN + 1184 * 1024, 0, -1},
    {8, 1024 * 7096, 0, 7096, 3992, 32, 1024, W_IN + 1440 * 1024, 0, -1},
    {8, 1024 * 7096, 0, 7096, 4024, 3072, 1024, W_IN + 3520 * 1024, 0, -1},
    {0, 0, 0, 0, 0, 8, 1024, W_IN + 792 * 1024, 3, -1}, {0, 0, 0, 0, 0, 64, 1024, W_IN + 6592 * 1024, 3, -1},
    {10, 2 * 2048 * 256, 0, 256, 0, 256, 2048, W_CMP, 0, -1}, {10, 2 * 2048 * 256, 2048 * 256, 256, 0, 256, 2048, W_CMP + 256 * 2048, 0, -1},
    {15, 384 * 768, 0, 768, 0, 768, 384, W_UQ, 0, 14},
    {17, 256 * 1024, 0, 1024, 0, 1024, 256, W_KN, 4, 16},
    {18, 3 * 512 * 1024, 0, 1024, 0, 1024, 512, W_BR, 0, -1}, {18, 3 * 512 * 1024, 512 * 1024, 1024, 0, 1024, 512, W_BR + 1024 * 512, 0, -1}, {18, 3 * 512 * 1024, 2 * 512 * 1024, 1024, 0, 1024, 512, W_BR + 2 * 1024 * 512, 0, -1},
    {19, 1048576, 0, 1024, 0, 1024, 1024, W_OUT, 0, -1}, {20, 1048576, 0, 1024, 0, 1024, 1024, W_XQ, 0, -1}, {23, 1048576, 0, 1024, 0, 1024, 1024, W_XO, 0, -1},
    {21, 1048576, 0, 1024, 0, 1024, 1024, W_XK, 0, -1}, {22, 1048576, 0, 1024, 0, 1024, 1024, W_XV, 0, -1},
};
__device__ __forceinline__ void phase_conv(const Args& a, int l, LAS unsigned char* lds) {
    LAS float* tile = (LAS float*)lds;
    bf16_t* W = (bf16_t*)(wsp(a) + WS_W);
    const int tid = tidx(), G = gdim();
    int rot = 0;
    for (int s = 0; s < NSEG; ++s) {
        const int src = SEGT[s][0], lstr = SEGT[s][1], extra = SEGT[s][2], ld = SEGT[s][3], col0 = SEGT[s][4], ncols = SEGT[s][5], K = SEGT[s][6], dsto = SEGT[s][7], mode = SEGT[s][8], ksrc = SEGT[s][9];
        const int ntn = (ncols + 127) >> 7, ntk = K >> 6, items = ntn * ntk;
        const float* S = (const float*)inp(a, src) + (size_t)l * lstr + extra;
        const float* KS = ksrc >= 0 ? (const float*)inp(a, ksrc) + (size_t)l * K : nullptr;
        bf16_t* D = W + dsto;
        int first = bidx() - rot; if (first < 0) first += G;
        const int kq = tid >> 5, n4 = (tid & 31) * 4;
        f32x4 pv[4]; float pks[4];
#pragma unroll
        for (int i = 0; i < 4; ++i) { pv[i] = (f32x4){0.f, 0.f, 0.f, 0.f}; pks[i] = 1.f; }
        if (first < items && mode != 3) { const int tn = first / ntk, tk = first % ntk, n0 = tn * 128, k0 = tk * 64;
#pragma unroll
            for (int i = 0; i < 4; ++i) { const int k = i * 16 + kq; if (n0 + n4 < ncols) { pv[i] = *(const f32x4*)(S + (size_t)(k0 + k) * ld + col0 + n0 + n4); if (KS) pks[i] = KS[k0 + k]; } } }
        for (int it = first; it < items; it += G) {
            const int tn = it / ntk, tk = it % ntk, n0 = tn * 128, k0 = tk * 64;
            if (mode != 3) {
#pragma unroll
                for (int i = 0; i < 4; ++i) { const int k = i * 16 + kq; const f32x4 v = pv[i] * pks[i];
                    tile[k * 129 + n4] = v[0]; tile[k * 129 + n4 + 1] = v[1]; tile[k * 129 + n4 + 2] = v[2]; tile[k * 129 + n4 + 3] = v[3]; }
            }
            __syncthreads();
            { const int nit = it + G;
              if (nit < items && mode != 3) { const int tn2 = nit / ntk, tk2 = nit % ntk, n02 = tn2 * 128, k02 = tk2 * 64;
#pragma unroll
                  for (int i = 0; i < 4; ++i) { const int k = i * 16 + kq; pv[i] = (f32x4){0.f, 0.f, 0.f, 0.f}; pks[i] = 1.f;
                      if (n02 + n4 < ncols) { pv[i] = *(const f32x4*)(S + (size_t)(k02 + k) * ld + col0 + n02 + n4); if (KS) pks[i] = KS[k02 + k]; } } } }
            { const int n = tid >> 2, kc = (tid & 3) * 16, nn = n0 + n;
              if (nn < ncols) {
                  int dr = nn;
                  if (mode == 1) dr = (nn >> 2) * 8 + (nn & 3); else if (mode == 2) dr = (nn >> 2) * 8 + 4 + (nn & 3); else if (mode == 4) dr = ((nn & 64) ? 512 : 0) + (nn >> 7) * 64 + (nn & 63);
                  u32x4 w0 = (u32x4){0u, 0u, 0u, 0u}, w1 = (u32x4){0u, 0u, 0u, 0u};
                  if (mode != 3) { const LAS float* tp = tile + kc * 129 + n;
                      w0.x = pk2(tp[0], tp[129]); w0.y = pk2(tp[2 * 129], tp[3 * 129]); w0.z = pk2(tp[4 * 129], tp[5 * 129]); w0.w = pk2(tp[6 * 129], tp[7 * 129]);
                      w1.x = pk2(tp[8 * 129], tp[9 * 129]); w1.y = pk2(tp[10 * 129], tp[11 * 129]); w1.z = pk2(tp[12 * 129], tp[13 * 129]); w1.w = pk2(tp[14 * 129], tp[15 * 129]); }
                  bf16_t* dp = D + (size_t)dr * K + k0 + kc; *(u32x4*)dp = w0; *(u32x4*)(dp + 8) = w1; } }
            __syncthreads();
        }
        rot = (rot + items) % G;
    }
}

__device__ __forceinline__ void phase_ln(const Args& a, int l, int j, bool do_bias) {
    const int lane = tidx() & 63, gw = bidx() * 8 + (tidx() >> 6), GW = gdim() * 8;
    const float* g = (const float*)inp(a, 3) + (size_t)(l * 4 + j) * DM; const float* bb = (const float*)inp(a, 4) + (size_t)(l * 4 + j) * DM;
    const float* Z = (const float*)(wsp(a) + WS_Z); float* XF = outp(a); bf16_t* XB = (bf16_t*)(wsp(a) + WS_XB);
    f32x4 gv[4], bv[4];
#pragma unroll
    for (int i = 0; i < 4; ++i) { gv[i] = *(const f32x4*)(g + i * 256 + lane * 4); bv[i] = *(const f32x4*)(bb + i * 256 + lane * 4); }
    for (int row = gw; row < T; row += GW) {
        f32x4 v[4]; float s = 0.f;
#pragma unroll
        for (int i = 0; i < 4; ++i) { v[i] = *(const f32x4*)(Z + (size_t)row * DM + i * 256 + lane * 4); s += (v[i][0] + v[i][1]) + (v[i][2] + v[i][3]); }
        const float mu = wave_sum(s) * (1.f / 1024.f); float q = 0.f;
#pragma unroll
        for (int i = 0; i < 4; ++i) { const f32x4 d = v[i] - mu; q += (d[0] * d[0] + d[1] * d[1]) + (d[2] * d[2] + d[3] * d[3]); }
        const float rstd = rsqrtf(wave_sum(q) * (1.f / 1024.f) + 1e-5f);
#pragma unroll
        for (int i = 0; i < 4; ++i) { const f32x4 o = (v[i] - mu) * rstd * gv[i] + bv[i]; *(f32x4*)(XF + (size_t)row * DM + i * 256 + lane * 4) = o;
            u32x2 w; w.x = pk2(o[0], o[1]); w.y = pk2(o[2], o[3]); *(u32x2*)(XB + (size_t)row * DM + i * 256 + lane * 4) = w; }
    }
    if (do_bias && gw < 512) {
        const int which = gw >> 8, n = gw & 255; const bf16_t* w = (const bf16_t*)(wsp(a) + WS_W) + W_CMP + (size_t)(which * 256 + n) * 2048;
        const float* pe = (const float*)inp(a, 9) + (size_t)(l * 2 + which) * 2048; float s = 0.f;
#pragma unroll
        for (int i = 0; i < 4; ++i) { const int k = i * 512 + lane * 8; const u32x4 ww = *(const u32x4*)(w + k); const f32x4 p0 = *(const f32x4*)(pe + k), p1 = *(const f32x4*)(pe + k + 4);
            s += bflo(ww.x) * p0[0] + bfhi(ww.x) * p0[1] + bflo(ww.y) * p0[2] + bfhi(ww.y) * p0[3] + bflo(ww.z) * p1[0] + bfhi(ww.z) * p1[1] + bflo(ww.w) * p1[2] + bfhi(ww.w) * p1[3]; }
        s = wave_sum(s); if (lane == 0) ((float*)(wsp(a) + WS_CBIAS))[gw] = s;
    }
}

__device__ __forceinline__ void s1_tokens(const Args& a) {
    const int lane = tidx() & 63, gw = bidx() * 8 + (tidx() >> 6), GW = gdim() * 8;
    bf16_t* P = (bf16_t*)(wsp(a) + WS_PROJ); const f32x2* ropeM = (const f32x2*)(wsp(a) + WS_ROPEM); const f32x2* ropeN = (const f32x2*)(wsp(a) + WS_ROPEN);
    bf16_t* kpe = (bf16_t*)(wsp(a) + WS_KPE); bf16_t* kfn = (bf16_t*)(wsp(a) + WS_KFN); float* rsq = (float*)(wsp(a) + WS_RSQ); float* rskv = (float*)(wsp(a) + WS_RSKV);
    for (int tok = gw; tok < T; tok += GW) {
        bf16_t* row = P + (size_t)tok * PLD;
        const int b = tok >> 11, sq = tok & 2047;
        { const int l5 = lane & 31, tg = l5 >> 3, ch = l5 & 7;
          u32x4 v = *(const u32x4*)(row + PC_KS + tg * 64 + ch * 8); u32x4 par;
          par.x = (unsigned)__shfl_xor((int)v.x, 1); par.y = (unsigned)__shfl_xor((int)v.y, 1); par.z = (unsigned)__shfl_xor((int)v.z, 1); par.w = (unsigned)__shfl_xor((int)v.w, 1);
          if (ch < 2) { const float sgn = (ch == 0) ? -1.f : 1.f; const unsigned ow[4] = {v.x, v.y, v.z, v.w}, pw[4] = {par.x, par.y, par.z, par.w}; unsigned rw[4];
#pragma unroll
              for (int j = 0; j < 4; ++j) { const f32x2 c0 = ropeN[tok * 8 + 2 * j], c1 = ropeN[tok * 8 + 2 * j + 1];
                  rw[j] = pk2(bflo(ow[j]) * c0.x + sgn * bflo(pw[j]) * c0.y, bfhi(ow[j]) * c1.x + sgn * bfhi(pw[j]) * c1.y); }
              v = (u32x4){rw[0], rw[1], rw[2], rw[3]}; }
          if (lane < 32) *(u32x4*)(kfn + (size_t)(((tg >> 1) * 8 + b) * 2 + (tg & 1)) * 131072 + kfrag_off(sq, ch * 8, 2)) = v; }
        if (lane >= 32 && lane < 48) { const int i = lane - 32; const float x1 = bf2f(row[PC_KR + i]), x2 = bf2f(row[PC_KR + 16 + i]); const f32x2 cs = ropeM[tok * 16 + i];
            const unsigned w = pk2(x1 * cs.x - x2 * cs.y, x2 * cs.x + x1 * cs.y); kpe[(size_t)b * 65536 + kfrag_off(sq, i, 1)] = (bf16_t)(w & 0xffffu); kpe[(size_t)b * 65536 + kfrag_off(sq, 16 + i, 1)] = (bf16_t)(w >> 16); }
        float s1 = 0.f, s2 = 0.f;
#pragma unroll
        for (int i = 0; i < 6; ++i) { const float v = bf2f(row[PC_CQ + i * 64 + lane]); s1 += v * v; }
#pragma unroll
        for (int i = 0; i < 4; ++i) { const float v = bf2f(row[PC_CKV + i * 64 + lane]); s2 += v * v; }
        s1 = wave_sum(s1); s2 = wave_sum(s2);
        if (lane == 0) { rsq[tok] = rsqrtf(s1 * (1.f / 384.f) + 1e-6f); rskv[tok] = rsqrtf(s2 * (1.f / 256.f) + 1e-6f); }
    }
}

__device__ __forceinline__ void hgrn_stage1(const Args& a, int l, int item, LAS unsigned char* lds) {
    constexpr int RS = 132, AS = 68, TS = 72;
    LAS float* q = (LAS float*)lds; LAS float* bb = q + 64 * RS; LAS float* kk = bb + 64 * RS; LAS float* Am = kk + 64 * RS; LAS float* X = Am + 64 * AS;
    LAS bf16_t* kT = (LAS bf16_t*)q;
    LAS bf16_t* vT = (LAS bf16_t*)X;
    LAS float* tot = X;
    const int tid = tidx(), lane = tid & 63, w = tid >> 6, fr = lane & 15, fq = lane >> 4; const int b = item >> 7, h = (item >> 5) & 3, c = item & 31; const int tok0 = b * SEQ + c * 64;
    bf16_t* P = (bf16_t*)(wsp(a) + WS_PROJ); const float* lbp = (const float*)(wsp(a) + WS_LB) + l * 512 + h * 128;
    for (int idx = tid; idx < 1024; idx += 512) { const int t = idx >> 4, d0 = (idx & 15) * 8; const bf16_t* row = P + (size_t)(tok0 + t) * PLD + h * 128 + d0;
        const u32x4 qw = *(const u32x4*)(row + PC_BQ), zw = *(const u32x4*)(row + PC_BF); const f32x4 l0 = *(const f32x4*)(lbp + d0), l1 = *(const f32x4*)(lbp + d0 + 4);
        const float qv[8] = {bflo(qw.x), bfhi(qw.x), bflo(qw.y), bfhi(qw.y), bflo(qw.z), bfhi(qw.z), bflo(qw.w), bfhi(qw.w)};
        const float zv[8] = {bflo(zw.x), bfhi(zw.x), bflo(zw.y), bfhi(zw.y), bflo(zw.z), bfhi(zw.z), bflo(zw.w), bfhi(zw.w)};
        const float lb[8] = {l0[0], l0[1], l0[2], l0[3], l1[0], l1[1], l1[2], l1[3]};
#pragma unroll
        for (int j = 0; j < 8; ++j) { const float en = ex2(-fminf(fmaxf(zv[j], -80.f), 80.f) * LOG2E), sg = rcpf(1.f + en), sgn = en * sg; const float f = lb[j] + (1.f - lb[j]) * sg;
            q[t * RS + d0 + j] = qv[j]; bb[t * RS + d0 + j] = __log2f(fmaxf(f, 1e-20f)); kk[t * RS + d0 + j] = (1.f - lb[j]) * sgn; } }
    __syncthreads();
    {
        const int d = tid & 127, p = tid >> 7; float vals[16]; float run = 0.f;
#pragma unroll
        for (int i = 0; i < 16; ++i) { run += bb[(16 * p + i) * RS + d]; vals[i] = run; }
        tot[p * 128 + d] = run;
        __syncthreads();
        float off = 0.f;
#pragma unroll
        for (int pp = 0; pp < 3; ++pp) off += (pp < p) ? tot[pp * 128 + d] : 0.f;
#pragma unroll
        for (int i = 0; i < 16; ++i) bb[(16 * p + i) * RS + d] = vals[i] + off;
    }
    __syncthreads();
    {
        const int I = tid >> 7, p = tid & 127, tr = 16 * I + (p >> 3), s0 = (p & 7) * 2, sr = 16 * I + s0; float a0 = 0.f, a1 = 0.f;
        for (int d = 0; d < 128; d += 4) { const f32x4 qt = *(const LAS f32x4*)(q + tr * RS + d), bt = *(const LAS f32x4*)(bb + tr * RS + d);
            const f32x4 k0 = *(const LAS f32x4*)(kk + sr * RS + d), b0 = *(const LAS f32x4*)(bb + sr * RS + d), k1 = *(const LAS f32x4*)(kk + (sr + 1) * RS + d), b1 = *(const LAS f32x4*)(bb + (sr + 1) * RS + d);
#pragma unroll
            for (int j = 0; j < 4; ++j) { a0 += qt[j] * k0[j] * ex2(fminf(bt[j] - b0[j], 0.f)); a1 += qt[j] * k1[j] * ex2(fminf(bt[j] - b1[j], 0.f)); } }
        Am[tr * AS + sr] = (s0 <= (p >> 3)) ? a0 : 0.f; Am[tr * AS + sr + 1] = (s0 + 1 <= (p >> 3)) ? a1 : 0.f;
        for (int idx = tid; idx < 1536; idx += 512) { const int blk = idx >> 8, e = idx & 255; const int bi = blk < 3 ? 0 : (blk < 5 ? 1 : 2), bj = blk < 3 ? blk + 1 : (blk < 5 ? blk - 1 : 3);
            Am[(16 * bi + (e >> 4)) * AS + 16 * bj + (e & 15)] = 0.f; }
    }
#pragma unroll 1
    for (int I = 1; I < 4; ++I) {
        __syncthreads();
        { const int nrows = 16 * I + 16; const LAS float* rr = bb + (16 * I - 1) * RS;
          for (int idx = tid; idx < nrows * 128; idx += 512) { const int row = idx >> 7, d = idx & 127; const float r = rr[d];
              if (row < 16 * I) X[row * RS + d] = kk[row * RS + d] * ex2(fminf(r - bb[row * RS + d], 0.f));
              else X[(48 + row - 16 * I) * RS + d] = q[row * RS + d] * ex2(fminf(bb[row * RS + d] - r, 0.f)); } }
        __syncthreads();
        { const int tp = tid & 15, sg = tid >> 4;
          for (int s = sg; s < 16 * I; s += 32) { float acc = 0.f;
              for (int d = 0; d < 128; d += 4) { const f32x4 x = *(const LAS f32x4*)(X + (48 + tp) * RS + d), y = *(const LAS f32x4*)(X + s * RS + d); acc += (x[0] * y[0] + x[1] * y[1]) + (x[2] * y[2] + x[3] * y[3]); }
              Am[(16 * I + tp) * AS + s] = acc; } }
    }
    __syncthreads();
    for (int idx = tid; idx < 1024; idx += 512) { const int t = idx >> 4, d0 = (idx & 15) * 8; float qd[8];
        const u32x4 vw = *(const u32x4*)(P + (size_t)(tok0 + t) * PLD + PC_BI + h * 128 + d0);
#pragma unroll
        for (int j = 0; j < 8; ++j) qd[j] = q[t * RS + d0 + j] * ex2(bb[t * RS + d0 + j]);
        u32x4 wv; wv.x = pk2(qd[0], qd[1]); wv.y = pk2(qd[2], qd[3]); wv.z = pk2(qd[4], qd[5]); wv.w = pk2(qd[6], qd[7]);
        *(u32x4*)(P + (size_t)(tok0 + t) * PLD + PC_BQ + h * 128 + d0) = wv;
        vT[(d0 + 0) * TS + t] = (bf16_t)(vw.x & 0xffffu); vT[(d0 + 1) * TS + t] = (bf16_t)(vw.x >> 16); vT[(d0 + 2) * TS + t] = (bf16_t)(vw.y & 0xffffu); vT[(d0 + 3) * TS + t] = (bf16_t)(vw.y >> 16);
        vT[(d0 + 4) * TS + t] = (bf16_t)(vw.z & 0xffffu); vT[(d0 + 5) * TS + t] = (bf16_t)(vw.z >> 16); vT[(d0 + 6) * TS + t] = (bf16_t)(vw.w & 0xffffu); vT[(d0 + 7) * TS + t] = (bf16_t)(vw.w >> 16); }
    if (tid < 128) ((float*)(wsp(a) + WS_DEC))[(size_t)item * 128 + tid] = ex2(bb[63 * RS + tid]);
    __syncthreads();
    for (int idx = tid; idx < 8192; idx += 512) { const int t = idx >> 7, d = idx & 127;
        const float kd = kk[t * RS + d] * ex2(bb[63 * RS + d] - bb[t * RS + d]);
        kT[d * TS + t] = (bf16_t)(pk2(kd, 0.f) & 0xffffu); }
    __syncthreads();
    {
        f32x4 acc[8];
#pragma unroll
        for (int et = 0; et < 8; ++et) acc[et] = (f32x4){0.f, 0.f, 0.f, 0.f};
#pragma unroll
        for (int ks = 0; ks < 2; ++ks) { const bf16x8 af = *(const LAS bf16x8*)(kT + (w * 16 + fr) * TS + ks * 32 + fq * 8);
#pragma unroll
            for (int et = 0; et < 8; ++et) acc[et] = mfma16(af, *(const LAS bf16x8*)(vT + (et * 16 + fr) * TS + ks * 32 + fq * 8), acc[et]); }
        float* st = (float*)(wsp(a) + WS_Z) + (size_t)item * 16384 + (size_t)fr * 128 + w * 16 + fq * 4;
#pragma unroll
        for (int et = 0; et < 8; ++et) *(f32x4*)(st + (size_t)et * 16 * 128) = acc[et];
    }
    {
        f32x4 acc[4];
#pragma unroll
        for (int tt = 0; tt < 4; ++tt) acc[tt] = (f32x4){0.f, 0.f, 0.f, 0.f};
#pragma unroll
        for (int ks = 0; ks < 2; ++ks) { const bf16x8 af = *(const LAS bf16x8*)(vT + (w * 16 + fr) * TS + ks * 32 + fq * 8);
#pragma unroll
            for (int tt = 0; tt < 4; ++tt) { const LAS float* ap = Am + (tt * 16 + fr) * AS + ks * 32 + fq * 8; const f32x4 x0 = *(const LAS f32x4*)ap, x1 = *(const LAS f32x4*)(ap + 4);
                u32x4 bw; bw.x = pk2(x0[0], x0[1]); bw.y = pk2(x0[2], x0[3]); bw.z = pk2(x1[0], x1[1]); bw.w = pk2(x1[2], x1[3]);
                acc[tt] = mfma16(af, __builtin_bit_cast(bf16x8, bw), acc[tt]); } }
#pragma unroll
        for (int tt = 0; tt < 4; ++tt) { u32x2 wv; wv.x = pk2(acc[tt][0], acc[tt][1]); wv.y = pk2(acc[tt][2], acc[tt][3]);
            *(u32x2*)(P + (size_t)(tok0 + tt * 16 + fr) * PLD + PC_BF + h * 128 + w * 16 + fq * 4) = wv; }
    }
    __syncthreads();
}
__device__ __forceinline__ void hgrn_scan(const Args& a) {
    const int gtid = bidx() * 512 + tidx(), GT = gdim() * 512; float* st = (float*)(wsp(a) + WS_Z); const float* dec = (const float*)(wsp(a) + WS_DEC);
    for (int idx = gtid; idx < 32 * 16384; idx += GT) { const int bh = idx >> 14, de = idx & 16383, d = de & 127;
        float kv[32], dc[32];
#pragma unroll
        for (int c = 0; c < 32; ++c) { const size_t ch = (size_t)bh * 32 + c; kv[c] = st[ch * 16384 + de]; dc[c] = dec[ch * 128 + d]; }
        float S = 0.f;
#pragma unroll
        for (int c = 0; c < 32; ++c) { const size_t ch = (size_t)bh * 32 + c; st[ch * 16384 + de] = S; S = dc[c] * S + kv[c]; } }
}
__device__ __forceinline__ void hgrn_stage3(const Args& a, int l, int item, int nitem, f32x4 (&sv)[8], LAS unsigned char* lds) {
    constexpr int TS2 = 136;
    LAS bf16_t* ST = (LAS bf16_t*)lds; LAS float* red = (LAS float*)(lds + 128 * TS2 * 2);
    const int tid = tidx(), lane = tid & 63, w = tid >> 6, fr = lane & 15, fq = lane >> 4; const int b = item >> 7, h = (item >> 5) & 3, c = item & 31; const int tok0 = b * SEQ + c * 64;
    const bf16_t* P = (const bf16_t*)(wsp(a) + WS_PROJ); const float* st = (const float*)(wsp(a) + WS_Z) + (size_t)item * 16384;
    bf16x8 qf[4][4];
#pragma unroll
    for (int ks = 0; ks < 4; ++ks)
#pragma unroll
        for (int tt = 0; tt < 4; ++tt) qf[ks][tt] = ld8(P + (size_t)(tok0 + tt * 16 + fr) * PLD + PC_BQ + h * 128 + ks * 32 + fq * 8);
    u32x2 iwv[4], gwv[4];
#pragma unroll
    for (int tt = 0; tt < 4; ++tt) { const bf16_t* row = P + (size_t)(tok0 + tt * 16 + fr) * PLD + h * 128 + w * 16 + fq * 4; iwv[tt] = *(const u32x2*)(row + PC_BF); gwv[tt] = *(const u32x2*)(row + PC_BG); }
#pragma unroll
    for (int i = 0; i < 8; ++i) { const int ii = tid + i * 512; u32x2 p; p.x = pk2(sv[i][0], sv[i][1]); p.y = pk2(sv[i][2], sv[i][3]); *(LAS u32x2*)(ST + (ii >> 5) * TS2 + (ii & 31) * 4) = p; }
    if (nitem < 1024) { const float* st2 = (const float*)(wsp(a) + WS_Z) + (size_t)nitem * 16384;
#pragma unroll
        for (int i = 0; i < 8; ++i) { const int ii = tid + i * 512; sv[i] = *(const f32x4*)(st2 + (ii >> 5) * 128 + (ii & 31) * 4); } }
    __syncthreads();
    f32x4 acc[4];
#pragma unroll
    for (int tt = 0; tt < 4; ++tt) acc[tt] = (f32x4){0.f, 0.f, 0.f, 0.f};
#pragma unroll
    for (int ks = 0; ks < 4; ++ks) { const bf16x8 af = *(const LAS bf16x8*)(ST + (w * 16 + fr) * TS2 + ks * 32 + fq * 8);
#pragma unroll
        for (int tt = 0; tt < 4; ++tt) acc[tt] = mfma16(af, qf[ks][tt], acc[tt]); }
    float o[4][4];
#pragma unroll
    for (int tt = 0; tt < 4; ++tt) { const u32x2 iw = iwv[tt];
        o[tt][0] = acc[tt][0] + bflo(iw.x); o[tt][1] = acc[tt][1] + bfhi(iw.x); o[tt][2] = acc[tt][2] + bflo(iw.y); o[tt][3] = acc[tt][3] + bfhi(iw.y);
        float ss = o[tt][0] * o[tt][0] + o[tt][1] * o[tt][1] + o[tt][2] * o[tt][2] + o[tt][3] * o[tt][3];
        ss = rsum_fq(ss);
        if (fq == 0) red[(tt * 16 + fr) * 8 + w] = ss; }
    __syncthreads();
    const float* ng = (const float*)inp(a, 13) + l * 128; const f32x4 gn = *(const f32x4*)(ng + w * 16 + fq * 4);
    bf16_t* yb = (bf16_t*)(wsp(a) + WS_YB);
#pragma unroll
    for (int tt = 0; tt < 4; ++tt) { const LAS float* rp = red + (tt * 16 + fr) * 8; const f32x4 r0 = *(const LAS f32x4*)rp, r1 = *(const LAS f32x4*)(rp + 4);
        const float tot = ((r0[0] + r0[1]) + (r0[2] + r0[3])) + ((r1[0] + r1[1]) + (r1[2] + r1[3])); const float rs = rsqrtf(tot * (1.f / 128.f) + 1e-6f);
        const u32x2 gw = gwv[tt];
        const float g0 = bflo(gw.x), g1 = bfhi(gw.x), g2 = bflo(gw.y), g3 = bfhi(gw.y);
        u32x2 wv; wv.x = pk2(o[tt][0] * rs * gn[0] * g0 * sigm(g0), o[tt][1] * rs * gn[1] * g1 * sigm(g1)); wv.y = pk2(o[tt][2] * rs * gn[2] * g2 * sigm(g2), o[tt][3] * rs * gn[3] * g3 * sigm(g3));
        *(u32x2*)(yb + (size_t)(tok0 + tt * 16 + fr) * 512 + h * 128 + w * 16 + fq * 4) = wv; }
    __syncthreads();
}

__device__ __forceinline__ void cmp_gemm2(const Args& a, int l) {
    const int gtid = bidx() * 512 + tidx(), GT = gdim() * 512;
    const bf16_t* hid = (const bf16_t*)(wsp(a) + WS_HID); const float* w2 = (const float*)inp(a, 11) + (size_t)l * 2 * 256 * 64;
    bf16_t* kc = (bf16_t*)(wsp(a) + WS_KCMP); bf16_t* vc = (bf16_t*)(wsp(a) + WS_VCMPT);
    for (int idx = gtid; idx < 2048 * 64; idx += GT) { const int r = idx >> 6, d = idx & 63;
        const bf16_t* h0 = hid + (size_t)r * 256; const bf16_t* h1 = hid + (size_t)(2048 + r) * 256; const float* w0 = w2 + d; const float* w1 = w2 + 16384 + d; float s0 = 0.f, s1 = 0.f;
#pragma unroll 1
        for (int k0 = 0; k0 < 256; k0 += 32) { u32x4 ha[4], hb[4]; float wa[32], wb[32];
#pragma unroll
            for (int q = 0; q < 4; ++q) { ha[q] = *(const u32x4*)(h0 + k0 + q * 8); hb[q] = *(const u32x4*)(h1 + k0 + q * 8); }
#pragma unroll
            for (int j = 0; j < 32; ++j) { wa[j] = w0[(k0 + j) * 64]; wb[j] = w1[(k0 + j) * 64]; }
#pragma unroll
            for (int q = 0; q < 4; ++q) {
                s0 += bflo(ha[q].x) * wa[q * 8 + 0] + bfhi(ha[q].x) * wa[q * 8 + 1] + bflo(ha[q].y) * wa[q * 8 + 2] + bfhi(ha[q].y) * wa[q * 8 + 3] + bflo(ha[q].z) * wa[q * 8 + 4] + bfhi(ha[q].z) * wa[q * 8 + 5] + bflo(ha[q].w) * wa[q * 8 + 6] + bfhi(ha[q].w) * wa[q * 8 + 7];
                s1 += bflo(hb[q].x) * wb[q * 8 + 0] + bfhi(hb[q].x) * wb[q * 8 + 1] + bflo(hb[q].y) * wb[q * 8 + 2] + bfhi(hb[q].y) * wb[q * 8 + 3] + bflo(hb[q].z) * wb[q * 8 + 4] + bfhi(hb[q].z) * wb[q * 8 + 5] + bflo(hb[q].w) * wb[q * 8 + 6] + bfhi(hb[q].w) * wb[q * 8 + 7]; } }
        kc[(size_t)(r >> 7) * 8192 + kfrag_off(r & 127, d, 2)] = (bf16_t)(pk2(s0, 0.f) & 0xffffu);
        vc[(size_t)(r >> 7) * 8192 + vfrag_off(r & 127, d)] = (bf16_t)(pk2(s1, 0.f) & 0xffffu); }
}

struct MaskSel { unsigned mymask; int jb, tcol; __device__ __forceinline__ bool operator()(int, int key) const { return ((mymask >> jb) & 1u) && key <= tcol; } };
struct MaskWin { int tcol; __device__ __forceinline__ bool operator()(int, int key) const { return key <= tcol && key > tcol - 256; } };
struct MaskCausal2 { int t0, t1; __device__ __forceinline__ bool operator()(int ct, int key) const { return key <= (ct ? t1 : t0); } };

__device__ __forceinline__ void nsa_item(const Args& a, int item, int lane) {
    const int fr = lane & 15, fq = lane >> 4;
    const int t4 = ((item & 511) + 128 * (item >> 11)) & 511, g = (item >> 9) & 1, b = item >> 10;
    const int t0 = t4 * 4, tq = fr >> 2, r = fr & 3, tcol = t0 + tq, tok = b * SEQ + tcol, head = g * 4 + r;
    const bf16_t* P = (const bf16_t*)(wsp(a) + WS_PROJ); const f32x2* ropeN = (const f32x2*)(wsp(a) + WS_ROPEN);
    const float cs = 0.125f * LOG2E;
    const bf16_t* qp = P + (size_t)tok * PLD + PC_Q + head * 64 + fq * 8;
    bf16x8 qg[1][2], qr[1][2]; qg[0][0] = ld8(qp); qg[0][1] = ld8(qp + 32); qr[0][1] = qg[0][1];
    { const u32x4 own = __builtin_bit_cast(u32x4, qg[0][0]); u32x4 par;
      par.x = (unsigned)__shfl_xor((int)own.x, 16); par.y = (unsigned)__shfl_xor((int)own.y, 16); par.z = (unsigned)__shfl_xor((int)own.z, 16); par.w = (unsigned)__shfl_xor((int)own.w, 16);
      u32x4 res = own;
      if (fq < 2) { const float sgn = (fq == 0) ? -1.f : 1.f; const unsigned ow[4] = {own.x, own.y, own.z, own.w}, pw[4] = {par.x, par.y, par.z, par.w}; unsigned rw[4];
#pragma unroll
          for (int j = 0; j < 4; ++j) { const f32x2 c0 = ropeN[tok * 8 + 2 * j], c1 = ropeN[tok * 8 + 2 * j + 1];
              rw[j] = pk2(bflo(ow[j]) * c0.x + sgn * bflo(pw[j]) * c0.y, bfhi(ow[j]) * c1.x + sgn * bfhi(pw[j]) * c1.y); }
          res = (u32x4){rw[0], rw[1], rw[2], rw[3]}; }
      qr[0][0] = __builtin_bit_cast(bf16x8, res); }
    const int gb = g * 8 + b;
    const bf16_t* kc = (const bf16_t*)(wsp(a) + WS_KCMP) + (size_t)gb * 8192; const bf16_t* vc = (const bf16_t*)(wsp(a) + WS_VCMPT) + (size_t)gb * 8192;
    const int nv = tcol >= 31 ? ((tcol - 31) >> 4) + 1 : 0;
    float sc[4][8]; float mx = -1.0e30f;
#pragma unroll
    for (int s4 = 0; s4 < 4; ++s4) {
#pragma unroll
        for (int u = 0; u < 2; ++u) { f32x4 s = (f32x4){0.f, 0.f, 0.f, 0.f};
#pragma unroll
            for (int dc = 0; dc < 2; ++dc) s = mfma16(ld8(kc + ((s4 * 2 + u) * 2 + dc) * 512 + lane * 8), qg[0][dc], s);
#pragma unroll
            for (int j = 0; j < 4; ++j) { const int n = s4 * 32 + fq * 8 + u * 4 + j; const float v = (n < nv) ? s[j] * cs : -1.0e30f; sc[s4][u * 4 + j] = v; mx = fmaxf(mx, v); } } }
    mx = rmax_fq(mx);
    float lsum = 0.f;
#pragma unroll
    for (int s4 = 0; s4 < 4; ++s4)
#pragma unroll
        for (int e = 0; e < 8; ++e) { const int n = s4 * 32 + fq * 8 + e; const float p = (n < nv) ? ex2(sc[s4][e] - mx) : 0.f; sc[s4][e] = p; lsum += p; }
    lsum = rsum_fq(lsum);
    const float linv = lsum > 0.f ? 1.f / lsum : 0.f;
    f32x4 ocmp[4];
#pragma unroll
    for (int dt = 0; dt < 4; ++dt) ocmp[dt] = (f32x4){0.f, 0.f, 0.f, 0.f};
#pragma unroll
    for (int s4 = 0; s4 < 4; ++s4) {
#pragma unroll
        for (int e = 0; e < 8; ++e) sc[s4][e] *= linv;
        u32x4 pw; pw.x = pk2(sc[s4][0], sc[s4][1]); pw.y = pk2(sc[s4][2], sc[s4][3]); pw.z = pk2(sc[s4][4], sc[s4][5]); pw.w = pk2(sc[s4][6], sc[s4][7]);
        const bf16x8 pb = __builtin_bit_cast(bf16x8, pw);
#pragma unroll
        for (int dt = 0; dt < 4; ++dt) ocmp[dt] = mfma16(ld8(vc + (s4 * 4 + dt) * 512 + lane * 8), pb, ocmp[dt]);
#pragma unroll
        for (int e = 0; e < 8; ++e) sc[s4][e] = rsum_quad(sc[s4][e]);
    }
    float val[8];
    const int cur = tcol >> 6;
#pragma unroll
    for (int s4 = 0; s4 < 4; ++s4) { const float prev = __shfl(sc[s4][7], (lane - 16) & 63); const float prevm1 = (s4 > 0) ? __shfl(sc[s4 > 0 ? s4 - 1 : 0][7], (lane - 16) & 63) : 0.f;
        const float pm1 = (fq > 0) ? prev : prevm1;
#pragma unroll
        for (int h2 = 0; h2 < 2; ++h2) { const float m1 = h2 ? sc[s4][3] : pm1;
            const float imp = 0.5f * m1 + sc[s4][4 * h2] + sc[s4][4 * h2 + 1] + sc[s4][4 * h2 + 2] + 0.5f * sc[s4][4 * h2 + 3];
            const int jb = 8 * s4 + 2 * fq + h2; const bool vld = (jb * 64 <= tcol), forced = (jb == 0) || (jb == cur) || (jb == cur - 1);
            val[s4 * 2 + h2] = vld ? (forced ? 1.0e9f : imp) : -1.0e9f; } }
    int rank[8];
#pragma unroll
    for (int k = 0; k < 8; ++k) rank[k] = 0;
#pragma unroll
    for (int dq = 0; dq < 4; ++dq) {
#pragma unroll
        for (int k2 = 0; k2 < 8; ++k2) { const float ov = __shfl(val[k2], fr | (dq << 4)); const int ojb = 8 * (k2 >> 1) + 2 * dq + (k2 & 1);
#pragma unroll
            for (int k = 0; k < 8; ++k) { const int jb = 8 * (k >> 1) + 2 * fq + (k & 1); rank[k] += (ov > val[k] || (ov == val[k] && ojb < jb)) ? 1 : 0; } } }
    unsigned mymask = 0u;
#pragma unroll
    for (int k = 0; k < 8; ++k) { const int jb = 8 * (k >> 1) + 2 * fq + (k & 1); if (val[k] > -0.5e9f && rank[k] < 8) mymask |= (1u << jb); }
    mymask |= (unsigned)__shfl_xor((int)mymask, 16); mymask |= (unsigned)__shfl_xor((int)mymask, 32);
    unsigned U = (unsigned)__builtin_amdgcn_readlane((int)mymask, 0) | (unsigned)__builtin_amdgcn_readlane((int)mymask, 4) | (unsigned)__builtin_amdgcn_readlane((int)mymask, 8) | (unsigned)__builtin_amdgcn_readlane((int)mymask, 12);
    const bf16_t* vtn = (const bf16_t*)(wsp(a) + WS_VTN);
    FAS ss[1]; fas_init(ss[0]);
    const bf16_t* kfn = (const bf16_t*)(wsp(a) + WS_KFN);
    { const bf16_t* ksb = kfn + (size_t)((0 * 8 + b) * 2 + g) * 131072; const bf16_t* const kb[2] = {ksb, ksb + 512}; const int kcs[2] = {1024, 1024};
      const bf16_t* vt = vtn + (size_t)((0 * 2 + g) * 8 + b) * 131072;
      while (U) { const int jb = __builtin_ctz(U); U &= U - 1u; const MaskSel mk{mymask, jb, tcol};
          fa_step2<1, 2>(ss, qr, kb, kcs, vt, jb * 64, cs, true, true, mk, lane); } }
    FAS sw[1]; fas_init(sw[0]);
    { const bf16_t* kwb = kfn + (size_t)((1 * 8 + b) * 2 + g) * 131072; const bf16_t* const kb[2] = {kwb, kwb + 512}; const int kcs[2] = {1024, 1024};
      const bf16_t* vt = vtn + (size_t)((1 * 2 + g) * 8 + b) * 131072; const MaskWin mk{tcol};
      int k0 = t0 - 255; if (k0 < 0) k0 = 0; k0 &= ~31;
      for (; k0 + 32 <= t0 + 3; k0 += 64) fa_step2<1, 2>(sw, qr, kb, kcs, vt, k0, cs, true, true, mk, lane);
      if (k0 <= t0 + 3) fa_step<1, 2>(sw, qr, kb, kcs, vt, k0, cs, true, mk, lane); }
    const bf16_t* gp = P + (size_t)tok * PLD + PC_GATE + head * 3;
    const float g0 = sigm(bf2f(gp[0])), g1 = sigm(bf2f(gp[1])) * (ss[0].l > 0.f ? 1.f / ss[0].l : 0.f), g2 = sigm(bf2f(gp[2])) * (sw[0].l > 0.f ? 1.f / sw[0].l : 0.f);
    bf16_t* ya = (bf16_t*)(wsp(a) + WS_YA) + (size_t)tok * 512 + head * 64;
#pragma unroll
    for (int dt = 0; dt < 4; ++dt) { float o[4];
#pragma unroll
        for (int j = 0; j < 4; ++j) { o[j] = 0.f;
#ifdef MK_NB
            if (MK_NB & 1) o[j] += g0 * ocmp[dt][j]; if (MK_NB & 2) o[j] += g1 * ss[0].o[dt][j]; if (MK_NB & 4) o[j] += g2 * sw[0].o[dt][j];
#else
            o[j] = g0 * ocmp[dt][j] + g1 * ss[0].o[dt][j] + g2 * sw[0].o[dt][j];
#endif
        }
#ifdef MK_SAN
#pragma unroll
        for (int j = 0; j < 4; ++j) if (!(fabsf(o[j]) < 1.0e6f)) o[j] = 0.f;
#endif
        u32x2 w; w.x = pk2(o[0], o[1]); w.y = pk2(o[2], o[3]); *(u32x2*)(ya + dt * 16 + fq * 4) = w; }
}

__device__ __forceinline__ void mla_item(const Args& a, int item, int wave, int lane) {
    const int fr = lane & 15, fq = lane >> 4; const int bh = item & 63, qb = item >> 6, b = bh >> 3, h = bh & 7;
    const int q0 = qb * 256 + wave * 32;
    const bf16_t* mq = (const bf16_t*)(wsp(a) + WS_MQ); const bf16_t* kn = (const bf16_t*)(wsp(a) + WS_KNOPE); const bf16_t* kpe = (const bf16_t*)(wsp(a) + WS_KPE); const bf16_t* vtm = (const bf16_t*)(wsp(a) + WS_VTM);
    bf16x8 qf[2][3];
#pragma unroll
    for (int ct = 0; ct < 2; ++ct)
#pragma unroll
        for (int dc = 0; dc < 3; ++dc) qf[ct][dc] = ld8(mq + (size_t)(b * SEQ + q0 + ct * 16 + fr) * 768 + h * 96 + dc * 32 + fq * 8);
    const bf16_t* knb = kn + (size_t)(h * 8 + b) * 131072; const bf16_t* const kb[3] = {knb, knb + 512, kpe + (size_t)b * 65536}; const int kcs[3] = {1024, 1024, 512};
    const bf16_t* vt = vtm + (size_t)(h * 8 + b) * 131072;
    FAS st[2]; fas_init(st[0]); fas_init(st[1]);
    const MaskCausal2 mk{q0 + fr, q0 + 16 + fr};
    { int k0 = 0;
      for (; k0 + 32 <= q0; k0 += 64) fa_step2<2, 3>(st, qf, kb, kcs, vt, k0, 1.0f, false, k0 + 63 > q0, mk, lane);
      if (k0 <= q0) fa_step<2, 3>(st, qf, kb, kcs, vt, k0, 1.0f, k0 + 31 > q0, mk, lane); }
    bf16_t* yc = (bf16_t*)(wsp(a) + WS_YC);
#pragma unroll
    for (int ct = 0; ct < 2; ++ct) { const float inv = st[ct].l > 0.f ? 1.f / st[ct].l : 0.f; bf16_t* yp = yc + (size_t)(b * SEQ + q0 + ct * 16 + fr) * 512 + h * 64;
#pragma unroll
        for (int dt = 0; dt < 4; ++dt) { u32x2 w; w.x = pk2(st[ct].o[dt][0] * inv, st[ct].o[dt][1] * inv); w.y = pk2(st[ct].o[dt][2] * inv, st[ct].o[dt][3] * inv); *(u32x2*)(yp + dt * 16 + fq * 4) = w; } }
}

__device__ __forceinline__ void cmp_bias(const Args& a, int l) {
    const int lane = tidx() & 63, gw = bidx() * 8 + (tidx() >> 6); if (gw >= 512) return;
    const int which = gw >> 8, n = gw & 255; const bf16_t* w = (const bf16_t*)(wsp(a) + WS_W) + W_CMP + (size_t)(which * 256 + n) * 2048;
    const float* pe = (const float*)inp(a, 9) + (size_t)(l * 2 + which) * 2048; float s = 0.f;
#pragma unroll
    for (int i = 0; i < 4; ++i) { const int k = i * 512 + lane * 8; const u32x4 ww = *(const u32x4*)(w + k); const f32x4 p0 = *(const f32x4*)(pe + k), p1 = *(const f32x4*)(pe + k + 4);
        s += bflo(ww.x) * p0[0] + bfhi(ww.x) * p0[1] + bflo(ww.y) * p0[2] + bfhi(ww.y) * p0[3] + bflo(ww.z) * p1[0] + bfhi(ww.z) * p1[1] + bflo(ww.w) * p1[2] + bfhi(ww.w) * p1[3]; }
    s = wave_sum(s); if (lane == 0) ((float*)(wsp(a) + WS_CBIAS))[gw] = s;
}

__device__ __forceinline__ bool store_job(const Args& a, int kind, int j, g8::Desc& d, g8::EpiStore& e) {
    unsigned char* ws = wsp(a); const bf16_t* W = (const bf16_t*)(ws + WS_W); bf16_t* xb = (bf16_t*)(ws + WS_XB); bf16_t* P = (bf16_t*)(ws + WS_PROJ);
    d.aBS1 = d.aBS2 = d.bBS1 = d.bBS2 = 0; d.nB = 1; d.nB2 = 1; d.boff = 0;
    e.oBS1 = e.oBS2 = 0; e.split_shift = 0; e.split_stride = 0; e.rowscale = nullptr; e.colscale = nullptr; e.bias = nullptr; e.act = 0; e.nB2 = 1; e.lay = 0;
    if (kind == 1) {
        if (j == 0) { d.A = (const bf16_t*)(ws + WS_MEMB); d.Bt = W + W_XK; d.lda = d.ldb = d.K = 1024; d.nM = 8; d.nN = 4; d.boff = 128; e.O = (bf16_t*)(ws + WS_XAK); e.ldc = 1024; return true; }
        if (j == 1) { d.A = W + W_XV; d.Bt = (const bf16_t*)(ws + WS_MEMB); d.lda = d.ldb = d.K = 1024; d.nM = 4; d.nN = 1; d.nB = 8; d.bBS1 = 256 * 1024; d.boff = 160; e.O = (bf16_t*)(ws + WS_XAVT); e.oBS1 = 1024 * 256; e.ldc = 256; return true; }
        return false;
    }
    if (kind == 4) {
        if (j == 0) { d.A = xb; d.Bt = W + W_IN; d.lda = d.ldb = d.K = 1024; d.nM = 64; d.nN = 26; e.O = P; e.ldc = PLD; return true; }
        if (j == 1) { d.A = xb; d.Bt = W + W_IN + 6656 * 1024; d.lda = d.ldb = d.K = 1024; d.nM = 64; d.nN = 1; d.boff = 128; e.O = (bf16_t*)(ws + WS_KCG); e.ldc = 64; e.split_shift = 6; e.split_stride = (long)T * 64; return true; }
        if (j == 2) { d.A = W + W_IN + 6912 * 1024; d.Bt = xb; d.lda = d.ldb = d.K = 1024; d.nM = 1; d.nN = 64; d.boff = 192; e.O = (bf16_t*)(ws + WS_VTN); e.ldc = T; e.lay = 1; return true; }
        return false;
    }
    if (kind == 5) {
        if (j < 2) { d.A = (const bf16_t*)(ws + WS_KCG) + (size_t)j * 2 * T * 64; d.Bt = W + W_CMP + j * 256 * 2048; d.lda = 1024; d.ldb = 2048; d.K = 2048; d.nM = 8; d.nN = 1; d.boff = j * 8;
            e.O = (bf16_t*)(ws + WS_HID) + (size_t)j * 2048 * 256; e.ldc = 256; e.bias = (const float*)(ws + WS_CBIAS) + j * 256; e.act = 1; return true; }
        return false;
    }
    if (kind == 6) {
        if (j == 0) { d.A = P + PC_CKV; d.Bt = W + W_KN; d.lda = PLD; d.ldb = 256; d.K = 256; d.nM = 64; d.nN = 2; d.boff = 192; e.O = (bf16_t*)(ws + WS_KNOPE); e.ldc = 512; e.rowscale = (const float*)(ws + WS_RSKV); e.lay = 2; return true; }
        if (j == 1) { d.A = W + W_VM; d.Bt = P + PC_CKV; d.lda = 256; d.ldb = PLD; d.K = 256; d.nM = 2; d.nN = 64; d.boff = 64; e.O = (bf16_t*)(ws + WS_VTM); e.ldc = T; e.colscale = (const float*)(ws + WS_RSKV); e.lay = 1; return true; }
        return false;
    }
    if (kind == 11) {
        if (j == 0) { d.A = xb; d.Bt = W + W_XQ; d.lda = d.ldb = d.K = 1024; d.nM = 64; d.nN = 4; e.O = (bf16_t*)(ws + WS_XQ); e.ldc = 1024; return true; }
        return false;
    }
    if (kind == 13) {
        if (j == 0) { d.A = (const bf16_t*)(ws + WS_XP); d.lda = 1024; d.Bt = (const bf16_t*)(ws + WS_XAVT); d.ldb = 256; d.K = 256; d.nM = 64; d.nN = 4;
            e.O = (bf16_t*)(ws + WS_XO); e.ldc = 1024; return true; }
        return false;
    }
    return false;
}

constexpr int NPL = 13, NPH = 1 + NLAYER * NPL;
__global__ void __launch_bounds__(512, 2) mk_fwd(Args a) {
    extern __shared__ __attribute__((aligned(16))) unsigned char lds_raw[];
    LAS unsigned char* lds = (LAS unsigned char*)lds_raw;
    volatile LAS unsigned* bst = (volatile LAS unsigned*)(lds + LDS_BYTES - 64);
    if (threadIdx.x == 0) { bst[0] = 0u; bst[1] = 0u; }
    __syncthreads();
#pragma unroll 1
    for (int ph = a.ph_lo; ph < a.ph_hi; ++ph) {
        unsigned char* ws = wsp(a);
        const int tid = tidx(), lane = tid & 63, wave = __builtin_amdgcn_readfirstlane(tid >> 6), G = gdim();
        const bf16_t* W = (const bf16_t*)(ws + WS_W); bf16_t* xb = (bf16_t*)(ws + WS_XB); bf16_t* P = (bf16_t*)(ws + WS_PROJ);
        if (ph == 0) {
#ifndef NO_INIT
            phase_init(a);
#endif
        }
        else {
            const int l = (ph - 1) / NPL, k = (ph - 1) % NPL;
            int kind;
            switch (k) { case 0: kind = 0; break; case 1: case 11: kind = 1; break; case 2: case 8: case 10: case 12: kind = 2; break; case 3: kind = 4; break; case 4: kind = 5; break; case 5: kind = 6; break;
                         case 6: kind = 7; break; case 7: kind = 8; break; default: kind = 11; break; }
#ifndef NO_CONV
            if (kind == 0) phase_conv(a, l, lds);
#endif
#ifndef NO_UP
            if (kind == 1) { g8::Desc d; d.A = xb; d.Bt = W + (k == 1 ? W_UP1 : W_UP2); d.aBS1 = d.aBS2 = d.bBS1 = d.bBS2 = 0; d.lda = d.ldb = d.K = 1024; d.nM = 64; d.nN = 22; d.nB = 1; d.nB2 = 1; d.boff = 0;
                g8::EpiSwiglu e{(bf16_t*)(ws + WS_H)}; g8::desc_defaults(d); g8::gemm_phase(lds, d, e); if (k == 1) cmp_bias(a, l); }
#endif
#ifndef NO_RESID
            if (kind == 2) { g8::Desc d; d.aBS1 = d.aBS2 = d.bBS1 = d.bBS2 = 0; d.nM = 64; d.nN = 4; d.nB = 1; d.nB2 = 1; d.boff = 0; float s = 1.f; int j = 0;
                if (k == 2 || k == 12) { d.A = (const bf16_t*)(ws + WS_H); d.Bt = W + (k == 2 ? W_DN1 : W_DN2); d.lda = d.ldb = d.K = DFF; s = 0.5f; j = (k == 2) ? 0 : 3; }
                else if (k == 8) { d.A = xb; d.Bt = W + W_OUT; d.lda = d.ldb = d.K = 1024; j = 1; }
                else { d.A = (const bf16_t*)(ws + WS_XO); d.Bt = W + W_XO; d.lda = d.ldb = d.K = 1024; j = 2; }
                g8::EpiLn e{(l == 0 && j == 0) ? (const float*)inp(a, 0) : (const float*)outp(a), outp(a), xb, (const float*)inp(a, 3) + (size_t)(l * 4 + j) * DM, (const float*)inp(a, 4) + (size_t)(l * 4 + j) * DM, s,
                            (unsigned long long*)(ws + WS_XBUF), (unsigned*)(ws + WS_CNT), 16u * (unsigned)(l * 4 + j + 1)};
                g8::desc_defaults(d); g8::gemm_phase(lds, d, e); }
#endif
#ifndef NO_MLAQ
            if (kind == 6) { g8::Desc d; d.A = P + PC_CQ; d.Bt = W + W_UQ; d.aBS1 = d.aBS2 = d.bBS1 = d.bBS2 = 0; d.lda = PLD; d.ldb = 384; d.K = 384; d.nM = 64; d.nN = 3; d.nB = 1; d.nB2 = 1; d.boff = 0;
                g8::EpiMlaQ e{(bf16_t*)(ws + WS_MQ), (const float*)(ws + WS_RSQ), (const f32x2*)(ws + WS_ROPEM)}; g8::desc_defaults(d); g8::gemm_phase(lds, d, e); }
#endif
#ifndef NO_STORE
            if (kind == 1 || kind == 4 || kind == 5 || kind == 6 || kind == 11) {
                if (!(kind == 1 && k != 1)) {
#pragma unroll 1
                    for (int j = 0; j < 3; ++j) { g8::Desc d; g8::EpiStore e; if (!store_job(a, kind, j, d, e)) break; if (kind == 11 && j > 0) break; g8::desc_defaults(d); g8::gemm_phase(lds, d, e); } } }
#endif
            if (kind == 5) {
#ifndef NO_S1TOK
                s1_tokens(a);
#endif
#ifndef NO_H1
                {
                    unsigned* qctr = (unsigned*)(ws + WS_BAR) + 12288 + l * 64; volatile LAS int* qs = (volatile LAS int*)(lds + LDS_BYTES - 128);
                    for (;;) { if (tid == 0) *qs = (int)__hip_atomic_fetch_add(qctr, 1u, __ATOMIC_RELAXED, __HIP_MEMORY_SCOPE_AGENT);
                        __syncthreads(); const int it = *qs; __syncthreads(); if (it >= 1024) break; hgrn_stage1(a, l, it, lds); } }
#endif
            }
#ifndef NO_S2X
            if (kind == 6) { cmp_gemm2(a, l); hgrn_scan(a); }
#endif
            if (kind == 7) {
#ifndef NO_NSA
                { const int gw = bidx() * 8 + wave; for (int it = gw; it < 8192; it += G * 8) nsa_item(a, it, lane); }
#endif
#ifndef NO_MLA
                { const int bx = bidx(); if (bx < 256) { mla_item(a, bx, wave, lane); mla_item(a, 511 - bx, wave, lane); } }
#endif
#ifndef NO_H3
                { f32x4 hsv[8]; { const float* st0 = (const float*)(ws + WS_Z) + (size_t)bidx() * 16384;
#pragma unroll
                      for (int i = 0; i < 8; ++i) { const int ii = tid + i * 512; hsv[i] = *(const f32x4*)(st0 + (ii >> 5) * 128 + (ii & 31) * 4); } }
                  for (int it = bidx(); it < 1024; it += G) hgrn_stage3(a, l, it, it + G, hsv, lds); }
#endif
            }
#ifndef NO_MERGE
            if (kind == 8) {
                { g8::Desc d; d.A = (const bf16_t*)(ws + WS_YA); d.Bt = W + W_BR; d.aBS1 = (long)T * 512; d.bBS1 = 1024 * 512; d.aBS2 = d.bBS2 = 0; d.lda = d.ldb = d.K = 512; d.nM = 64; d.nN = 4; d.nB = 3; d.nB2 = 1; d.boff = 0;
                  g8::EpiMerge e{P, (float*)(ws + WS_Z), xb, 0}; g8::desc_defaults(d); d.bmode = 1; g8::gemm_phase(lds, d, e); } }
#endif
#ifndef NO_XAS
            if (kind == 11) {
                { g8::Desc d; d.A = (const bf16_t*)(ws + WS_XQ); d.Bt = (const bf16_t*)(ws + WS_XAK); d.aBS1 = d.aBS2 = d.bBS1 = d.bBS2 = 0; d.lda = 1024; d.ldb = 1024; d.K = 256; d.nM = 64; d.nN = 4; d.nB = 1; d.nB2 = 1; d.boff = 0;
                  d.aN = 256; d.bN = 256; d.bB = 256 * 1024; d.bmode = 0;
                  g8::EpiXaSoft e{(bf16_t*)(ws + WS_XP), 0, 0, 1024, 1, 0.0625f * LOG2E}; g8::gemm_phase(lds, d, e); }
                { g8::Desc d; g8::EpiStore e; (void)store_job(a, 13, 0, d, e); d.aN = 256; d.bN = 256 * 256; d.bB = 1024 * 256; d.bmode = 0; g8::gemm_phase(lds, d, e); } }
#endif
        }
        if (ph + 1 < a.ph_hi) {
            if (ph == 0) {
                cg::this_grid().sync();
                if (threadIdx.x == 0) (void)xb_add(&((unsigned*)(wsp(a) + WS_BAR))[XB_XCNT(xb_xcc_id())], 1u);
            } else xcd_barrier((unsigned*)(wsp(a) + WS_BAR), bst);
        }
    }
}

#ifndef MK_PH_HI
#define MK_PH_HI NPH
#endif
#ifndef MK_ONE_LAUNCH
#define MK_ONE_LAUNCH 1
#endif
extern "C" void kernel_launch(void* const* d_in, const int* in_sizes, int n_in, void* d_out, int out_size, void* d_ws, size_t ws_size, hipStream_t stream) {
    static int grid = 0;
    if (grid == 0) {
        if (n_in != 24 || out_size != T * DM || ws_size < WS_END) { fprintf(stderr, "kernel_launch: unexpected problem (n_in %d out %d ws %zu need %zu)\n", n_in, out_size, ws_size, (size_t)WS_END); grid = -1; return; }
        int dev = 0, cus = 0;
        if (hipGetDevice(&dev) != hipSuccess || hipDeviceGetAttribute(&cus, hipDeviceAttributeMultiprocessorCount, dev) != hipSuccess) { grid = -1; return; }
        if (hipFuncSetAttribute((const void*)mk_fwd, hipFuncAttributeMaxDynamicSharedMemorySize, LDS_BYTES) != hipSuccess) { fprintf(stderr, "kernel_launch: hipFuncSetAttribute failed\n"); grid = -1; return; }
        (void)hipGetLastError();
        grid = cus;
        if (grid != 256) fprintf(stderr, "kernel_launch: %d CUs (built for 256)\n", grid);
    }
    if (grid < 0) return;
    Args a{};
    for (int i = 0; i < 24; ++i) a.in[i] = d_in[i];
    a.out = (float*)d_out; a.ws = (unsigned char*)d_ws;
#if MK_ONE_LAUNCH
    a.ph_lo = 0; a.ph_hi = MK_PH_HI;
    void* args[] = {&a};
    hipError_t e = hipLaunchCooperativeKernel((const void*)mk_fwd, dim3(grid), dim3(512), args, LDS_BYTES, stream);
    if (e != hipSuccess) fprintf(stderr, "kernel_launch: cooperative launch failed: %s\n", hipGetErrorString(e));
#else
    for (int ph = 0; ph < NPH; ++ph) { a.ph_lo = ph; a.ph_hi = ph + 1; hipLaunchKernelGGL(mk_fwd, dim3(grid), dim3(512), LDS_BYTES, stream, a); }
#endif
}
```

```cpp
#include <hip/hip_runtime.h>
#include <hip/hip_cooperative_groups.h>
#include <cstdio>
#include <cstdint>
namespace cg = cooperative_groups;

#define LAS __attribute__((address_space(3)))
typedef unsigned short bf16_t;
typedef short bf16x8 __attribute__((ext_vector_type(8)));
typedef float f32x4 __attribute__((ext_vector_type(4)));
typedef float f32x2 __attribute__((ext_vector_type(2)));
typedef unsigned u32x4 __attribute__((ext_vector_type(4)));
typedef unsigned u32x2 __attribute__((ext_vector_type(2)));

constexpr int T = 16384, DM = 1024, SEQ = 2048, DFF = 2816, NLAYER = 4, PLD = 6656;
constexpr float ALPHA = 1.6817928305074292f, LOG2E = 1.4426950408889634f;
constexpr int PC_Q = 0, PC_KS = 512, PC_KW = 640, PC_GATE = 768, PC_CQ = 800, PC_CKV = 1184, PC_KR = 1440, PC_BQ = 1472, PC_BF = 1984, PC_BI = 2496, PC_BG = 3008, PC_MG = 3520;
constexpr size_t MiB = 1048576;
constexpr size_t WS_LB = 0, WS_CBIAS = 8192, WS_RSQ = 65536, WS_RSKV = 131072, WS_DEC = 262144, WS_KCMP = 1 * MiB, WS_VCMPT = 1 * MiB + 262144;
constexpr size_t WS_CNT = 819200 + 16384;
constexpr size_t WS_BAR = 819200;
constexpr size_t WS_ROPEM = 2 * MiB, WS_ROPEN = 4 * MiB, WS_W = 5 * MiB, WS_XB = 69 * MiB, WS_Z = 101 * MiB, WS_S = 165 * MiB;
constexpr size_t WS_H = WS_S, WS_PROJ = WS_S, WS_KCG = WS_S + 208 * MiB, WS_VTN = WS_S + 217 * MiB, WS_HID = WS_S + 225 * MiB, WS_MQ = WS_S + 227 * MiB;
constexpr size_t WS_KNOPE = WS_S + 251 * MiB, WS_VTM = WS_S + 267 * MiB, WS_KPE = WS_S + 283 * MiB, WS_YA = WS_S + 284 * MiB, WS_YB = WS_S + 300 * MiB, WS_YC = WS_S + 316 * MiB;
constexpr size_t WS_XAK = WS_S + 332 * MiB, WS_XAVT = WS_S + 336 * MiB, WS_MEMB = WS_S + 340 * MiB, WS_KFN = WS_S + 344 * MiB, WS_XBUF = WS_S + 352 * MiB, WS_END = WS_S + 354 * MiB;
constexpr size_t WS_XQ = WS_S, WS_XP = WS_S + 32 * MiB, WS_XO = WS_S + 64 * MiB;
constexpr int W_UP1 = 0, W_DN1 = W_UP1 + 5632 * 1024, W_UP2 = W_DN1 + 1024 * 2816, W_DN2 = W_UP2 + 5632 * 1024, W_IN = W_DN2 + 1024 * 2816;
constexpr int W_CMP = W_IN + 7168 * 1024, W_UQ = W_CMP + 2 * 256 * 2048, W_KN = W_UQ + 768 * 384, W_VM = W_KN + 512 * 256, W_BR = W_VM + 512 * 256;
constexpr int W_OUT = W_BR + 3 * 1024 * 512, W_XQ = W_OUT + 1048576, W_XO = W_XQ + 1048576, W_XK = W_XO + 1048576, W_XV = W_XK + 1048576, W_ENDE = W_XV + 1048576;
static_assert((size_t)W_ENDE * 2 <= 64 * MiB, "weights region");
constexpr int LDS_BYTES = 155648;

__device__ __forceinline__ float bf2f(bf16_t v) { return __builtin_bit_cast(float, (unsigned)v << 16); }
__device__ __forceinline__ float bflo(unsigned w) { return __builtin_bit_cast(float, w << 16); }
__device__ __forceinline__ float bfhi(unsigned w) { return __builtin_bit_cast(float, w & 0xffff0000u); }
typedef __bf16 bf16x2_t __attribute__((ext_vector_type(2)));
__device__ __forceinline__ unsigned pk2(float lo, float hi) { const f32x2 v = {lo, hi}; const bf16x2_t b = __builtin_convertvector(v, bf16x2_t); return __builtin_bit_cast(unsigned, b); }
__device__ __forceinline__ float ex2(float x) { return __builtin_amdgcn_exp2f(x); }
__device__ __forceinline__ float rcpf(float x) { return __builtin_amdgcn_rcpf(x); }
__device__ __forceinline__ float sigm(float x) { return rcpf(1.f + ex2(-x * LOG2E)); }
__device__ __forceinline__ float wave_sum(float v) {
#pragma unroll
    for (int o = 1; o < 64; o <<= 1) v += __shfl_xor(v, o);
    return v;
}

__device__ __forceinline__ int tidx() { int t = threadIdx.x; asm volatile("" : "+v"(t)); return t; }
__device__ __forceinline__ int bidx() { int t = blockIdx.x; asm volatile("" : "+s"(t)); return t; }
__device__ __forceinline__ int gdim() { int t = gridDim.x; asm volatile("" : "+s"(t)); return t; }
__device__ __forceinline__ float rmax_fq(float x) { const unsigned u = __builtin_bit_cast(unsigned, x);
    auto r = __builtin_amdgcn_permlane16_swap(u, u, false, false); float y = fmaxf(__builtin_bit_cast(float, (unsigned)r[0]), __builtin_bit_cast(float, (unsigned)r[1]));
    const unsigned v = __builtin_bit_cast(unsigned, y); auto q = __builtin_amdgcn_permlane32_swap(v, v, false, false); return fmaxf(__builtin_bit_cast(float, (unsigned)q[0]), __builtin_bit_cast(float, (unsigned)q[1])); }
__device__ __forceinline__ float rsum_fq(float x) { const unsigned u = __builtin_bit_cast(unsigned, x);
    auto r = __builtin_amdgcn_permlane16_swap(u, u, false, false); float y = __builtin_bit_cast(float, (unsigned)r[0]) + __builtin_bit_cast(float, (unsigned)r[1]);
    const unsigned v = __builtin_bit_cast(unsigned, y); auto q = __builtin_amdgcn_permlane32_swap(v, v, false, false); return __builtin_bit_cast(float, (unsigned)q[0]) + __builtin_bit_cast(float, (unsigned)q[1]); }
__device__ __forceinline__ float rsum_quad(float x) { float y = x + __builtin_bit_cast(float, __builtin_amdgcn_update_dpp(0, __builtin_bit_cast(int, x), 0xB1, 0xF, 0xF, false));
    return y + __builtin_bit_cast(float, __builtin_amdgcn_update_dpp(0, __builtin_bit_cast(int, y), 0x4E, 0xF, 0xF, false)); }
__device__ __forceinline__ f32x4 mfma16(bf16x8 a, bf16x8 b, f32x4 c) { return __builtin_amdgcn_mfma_f32_16x16x32_bf16(a, b, c, 0, 0, 0); }
__device__ __forceinline__ bf16x8 ld8(const bf16_t* p) { return *(const bf16x8*)p; }
__device__ __forceinline__ int kfrag_off(int s, int d, int ndc) { const int kb32 = s >> 5, r = s & 31, u = (r >> 2) & 1, fr = (r >> 3) * 4 + (r & 3), dc = d >> 5, fq = (d >> 3) & 3, j = d & 7;
    return (((kb32 * 2 + u) * ndc + dc) * 64 + fq * 16 + fr) * 8 + j; }
__device__ __forceinline__ int vfrag_off(int s, int dv) { const int kb32 = s >> 5, fq = (s >> 3) & 3, j = s & 7, dt = dv >> 4, fr = dv & 15; return ((kb32 * 4 + dt) * 64 + fq * 16 + fr) * 8 + j; }

namespace g8 {
constexpr int BM = 256, BK = 64, HALF = 128, HTB = HALF * BK * 2, NXCD = 8, WGM = 8;
__device__ __forceinline__ int lds_byte(int r, int c) { const int st = (r >> 4) * 2 + (c >> 5), rr = r & 15, cc = c & 31, ob = rr * 64 + cc * 2; return st * 1024 + (ob ^ (((ob >> 9) & 1) << 5)); }
__device__ __forceinline__ void stage_rc(int b, int& R, int& C) { const int st = b / 1024, sb = b % 1024, swz = sb ^ (((sb >> 9) & 1) << 5); R = (st >> 1) * 16 + swz / 64; C = (st & 1) * 32 + (swz % 64) / 2; }
__device__ __forceinline__ int perm32(int rho) { const int n = rho >> 4, i = rho & 15; return 8 * (i >> 2) + 4 * n + (i & 3); }
struct Unit { int b, pm, pn; };
struct Desc { const bf16_t* A; const bf16_t* Bt; long aBS1, aBS2, bBS1, bBS2; int lda, ldb, K, nM, nN, nB, nB2, boff; long aN, bN, bB; int bmode; };
__device__ __forceinline__ void desc_defaults(Desc& d) { d.aN = 0; d.bN = (long)BM * d.ldb; d.bB = 0; d.bmode = 0; }
__device__ __forceinline__ bool get_unit(const Desc& d, int i, Unit& u) {
    const int G = gdim(); int c = bidx() - d.boff; if (c < 0) c += G;
    const int per = d.nM * d.nN, nwg = d.bmode ? per : per * d.nB; const long L = d.bmode ? (long)c : (long)i * G + c; if (L >= nwg || (d.bmode && i >= d.nB)) return false;
    int wgid = (int)L; { const int q = nwg / NXCD, r = nwg % NXCD, xcd = wgid % NXCD, off = wgid / NXCD; wgid = (xcd < r ? xcd * (q + 1) : r * (q + 1) + (xcd - r) * q) + off; }
    u.b = d.bmode ? i : wgid / per; const int w = wgid % per;
    const int nig = WGM * d.nN, gid = w / nig, fm = gid * WGM, gsz = (d.nM - fm) < WGM ? (d.nM - fm) : WGM;
    u.pm = fm + ((w % nig) % gsz); u.pn = (w % nig) / gsz; return true;
}
template <class Epi>
__device__ __forceinline__ void gemm_phase(LAS unsigned char* lds, const Desc& g, const Epi& E) {
    const int tid = tidx(), wid = __builtin_amdgcn_readfirstlane(tid >> 6), lane = tid & 63, wr = wid >> 2, wc = wid & 3, fr = lane & 15, fq = lane >> 4;
    const int K = g.K, nt = K / BK;
    unsigned voffA[2], voffB[2];
#pragma unroll
    for (int i = 0; i < 2; ++i) { int R, C; stage_rc(tid * 16 + i * 8192, R, C); const int Rb = (R & ~31) + perm32(R & 31);
        voffA[i] = (unsigned)(R * g.lda + C) * 2u; voffB[i] = (unsigned)(Rb * g.ldb + C) * 2u; }
    const size_t kstep = (size_t)(BK * 2);
    const size_t hstepA = (size_t)HALF * g.lda * 2, hstepB = (size_t)HALF * g.ldb * 2;
    const unsigned ldsw = (unsigned)wid * 1024u;
    const int aoff = lds_byte(wr * 64 + fr, fq * 8), boff = lds_byte(wc * 32 + fr, fq * 8);
#define G8_SA(b, h) (((b) * 2 + (h)) * HTB)
#define G8_SB(b, h) ((4 + (b) * 2 + (h)) * HTB)
#define G8_STAGE(bufoff, gbase, voff) do { _Pragma("unroll") for (int _i = 0; _i < 2; ++_i) \
        __builtin_amdgcn_global_load_lds((const unsigned*)((const char*)(gbase) + (voff)[_i]), (LAS unsigned*)(lds + (bufoff) + ldsw + _i * 8192), 16, 0, 0); } while (0)
#define G8_LDA(dst, b, h) do { _Pragma("unroll") for (int m = 0; m < 4; ++m) _Pragma("unroll") for (int k = 0; k < 2; ++k) dst[m][k] = *(const LAS bf16x8*)(lds + G8_SA(b, h) + aoff + m * 2048 + k * 1024); } while (0)
#define G8_LDB(dst, b, h) do { _Pragma("unroll") for (int n = 0; n < 2; ++n) _Pragma("unroll") for (int k = 0; k < 2; ++k) dst[n][k] = *(const LAS bf16x8*)(lds + G8_SB(b, h) + boff + n * 2048 + k * 1024); } while (0)
#define G8_MMA(ai, bj, At, Bt) do { __builtin_amdgcn_s_setprio(1); _Pragma("unroll") for (int m = 0; m < 4; ++m) _Pragma("unroll") for (int n = 0; n < 2; ++n) _Pragma("unroll") for (int k = 0; k < 2; ++k) \
        acc[ai][bj][m][n] = __builtin_amdgcn_mfma_f32_16x16x32_bf16(Bt[n][k], At[m][k], acc[ai][bj][m][n], 0, 0, 0); __builtin_amdgcn_s_setprio(0); } while (0)
#define G8_WAIT_V(n) asm volatile("s_waitcnt vmcnt(" #n ")" ::: "memory")
#define G8_WAIT_L(n) asm volatile("s_waitcnt lgkmcnt(" #n ")" ::: "memory")
#define G8_BAR __builtin_amdgcn_s_barrier()
#define G8_SCHED __builtin_amdgcn_sched_barrier(0)
#define G8_UA(u) ((const char*)g.A + 2 * ((size_t)((u).b / g.nB2) * g.aBS1 + (size_t)((u).b % g.nB2) * g.aBS2 + (size_t)(u).pm * BM * g.lda + (size_t)(u).pn * g.aN))
#define G8_UB(u) ((const char*)g.Bt + 2 * ((size_t)((u).b / g.nB2) * g.bBS1 + (size_t)((u).b % g.nB2) * g.bBS2 + (size_t)(u).pn * g.bN + (size_t)((u).pm >> 3) * g.bB))
    Unit cur, nxt; int ui = 0;
    if (!get_unit(g, 0, cur)) return;
    f32x4 acc[2][2][4][2];
#pragma unroll
    for (int a = 0; a < 2; ++a)
#pragma unroll
        for (int b = 0; b < 2; ++b)
#pragma unroll
            for (int m = 0; m < 4; ++m)
#pragma unroll
                for (int n = 0; n < 2; ++n) acc[a][b][m][n] = (f32x4){0.f, 0.f, 0.f, 0.f};
    bf16x8 At[4][2], B0[2][2], B1[2][2];
    const char* cA = G8_UA(cur); const char* cB = G8_UB(cur);
    G8_STAGE(G8_SB(0, 0), cB, voffB); G8_STAGE(G8_SB(0, 1), cB + hstepB, voffB); G8_STAGE(G8_SA(0, 0), cA, voffA); G8_STAGE(G8_SA(0, 1), cA + hstepA, voffA);
    if (wr == 1) G8_BAR;
    G8_WAIT_V(2); G8_BAR;
    G8_STAGE(G8_SB(1, 0), cB + kstep, voffB); G8_STAGE(G8_SA(1, 0), cA + kstep, voffA); G8_STAGE(G8_SB(1, 1), cB + hstepB + kstep, voffB);
    G8_WAIT_V(6); G8_BAR;
    for (;;) {
        const bool has_next = get_unit(g, ui + 1, nxt);
        const char* nA = has_next ? G8_UA(nxt) : cA; const char* nB = has_next ? G8_UB(nxt) : cB;
        for (int t = 0; t < nt; t += 2) {
            const bool last = (t == nt - 2);
            const char* a1 = cA + (size_t)(t + 1) * kstep;
            const char* a2 = last ? nA : cA + (size_t)(t + 2) * kstep; const char* b2 = last ? nB : cB + (size_t)(t + 2) * kstep;
            const char* a3 = a2 + kstep; const char* b3 = b2 + kstep;
            G8_LDB(B0, 0, 0); G8_LDB(B1, 0, 1); G8_SCHED; G8_LDA(At, 0, 0); G8_STAGE(G8_SA(1, 1), a1 + hstepA, voffA);
            G8_WAIT_V(8); G8_WAIT_L(0); G8_BAR; G8_MMA(0, 0, At, B0); G8_MMA(0, 1, At, B1); G8_BAR; G8_SCHED;
            G8_LDA(At, 0, 1); G8_STAGE(G8_SB(0, 0), b2, voffB); G8_STAGE(G8_SB(0, 1), b2 + hstepB, voffB); G8_STAGE(G8_SA(0, 0), a2, voffA);
            G8_WAIT_V(8); G8_WAIT_L(0); G8_BAR; G8_MMA(1, 0, At, B0); G8_MMA(1, 1, At, B1); G8_BAR; G8_SCHED;
            G8_LDB(B0, 1, 0); G8_LDB(B1, 1, 1); G8_SCHED; G8_LDA(At, 1, 0); G8_STAGE(G8_SA(0, 1), a2 + hstepA, voffA);
            G8_WAIT_V(8); G8_WAIT_L(0); G8_BAR; G8_MMA(0, 0, At, B0); G8_MMA(0, 1, At, B1); G8_BAR; G8_SCHED;
            G8_LDA(At, 1, 1); G8_STAGE(G8_SB(1, 0), b3, voffB); G8_STAGE(G8_SB(1, 1), b3 + hstepB, voffB); G8_STAGE(G8_SA(1, 0), a3, voffA);
            G8_WAIT_V(8); G8_WAIT_L(0); G8_BAR; G8_MMA(1, 0, At, B0); G8_MMA(1, 1, At, B1); G8_BAR; G8_SCHED;
        }
        if (wr == 0) G8_BAR;
        if constexpr (!Epi::AFTER_DRAIN) { E(acc, cur, wr, wc, fr, fq); }
        if (!has_next) break;
        if (!g.bmode) {
#pragma unroll
        for (int a = 0; a < 2; ++a)
#pragma unroll
            for (int b = 0; b < 2; ++b)
#pragma unroll
                for (int m = 0; m < 4; ++m)
#pragma unroll
                    for (int n = 0; n < 2; ++n) acc[a][b][m][n] = (f32x4){0.f, 0.f, 0.f, 0.f};
        }
        cur = nxt; cA = nA; cB = nB; ++ui;
        if (wr == 1) G8_BAR;
    }
    G8_WAIT_V(0);
    G8_BAR;
    if constexpr (Epi::AFTER_DRAIN) { E.fused(acc, cur, wr, wc, fr, fq, lds, wid, lane); }
}

struct EpiSwiglu { static constexpr bool AFTER_DRAIN = false; bf16_t* H;
    __device__ __forceinline__ void operator()(const f32x4 (&acc)[2][2][4][2], const Unit& u, int wr, int wc, int fr, int fq) const {
        const int row0 = u.pm * BM + wr * 64 + fr, hc0 = u.pn * 128 + wc * 16 + fq * 4;
#pragma unroll
        for (int ai = 0; ai < 2; ++ai)
#pragma unroll
            for (int m = 0; m < 4; ++m) { bf16_t* rp = H + (size_t)(row0 + ai * HALF + m * 16) * DFF + hc0;
#pragma unroll
                for (int bj = 0; bj < 2; ++bj) { const f32x4 a = acc[ai][bj][m][0], b = acc[ai][bj][m][1]; float h[4];
#pragma unroll
                    for (int j = 0; j < 4; ++j) h[j] = a[j] * sigm(a[j]) * b[j];
                    u32x2 w; w.x = pk2(h[0], h[1]); w.y = pk2(h[2], h[3]); *(u32x2*)(rp + bj * 64) = w; } }
    }
};
struct EpiResid { static constexpr bool AFTER_DRAIN = false; const float* X; float* Z; float s;
    __device__ __forceinline__ void operator()(const f32x4 (&acc)[2][2][4][2], const Unit& u, int wr, int wc, int fr, int fq) const {
        const int row0 = u.pm * BM + wr * 64 + fr, c0 = u.pn * BM + wc * 32 + fq * 8;
#pragma unroll
        for (int ai = 0; ai < 2; ++ai)
#pragma unroll
            for (int m = 0; m < 4; ++m) { const size_t ro = (size_t)(row0 + ai * HALF + m * 16) * DM + c0;
#pragma unroll
                for (int bj = 0; bj < 2; ++bj)
#pragma unroll
                    for (int n = 0; n < 2; ++n) { const f32x4 x = *(const f32x4*)(X + ro + bj * HALF + n * 4); *(f32x4*)(Z + ro + bj * HALF + n * 4) = x * ALPHA + acc[ai][bj][m][n] * s; } }
    }
};
struct EpiLn { static constexpr bool AFTER_DRAIN = false; const float* XI; float* XF; bf16_t* XB; const float* g; const float* bt; float s; unsigned long long* xbuf; unsigned* cnt; unsigned target;
    __device__ __forceinline__ void operator()(f32x4 (&acc)[2][2][4][2], const Unit& u, int wr, int wc, int fr, int fq) const {
        const int row0 = u.pm * BM + wr * 64 + fr, c0 = u.pn * BM + wc * 32 + fq * 8;
        unsigned long long* xb0 = xbuf + ((size_t)u.pm * 256 + wr * 64 + fr) * 16;
#pragma unroll
        for (int ai = 0; ai < 2; ++ai)
#pragma unroll
            for (int m = 0; m < 4; ++m) { const size_t ro = (size_t)(row0 + ai * HALF + m * 16) * DM + c0; float s1 = 0.f, s2 = 0.f;
#pragma unroll
                for (int bj = 0; bj < 2; ++bj)
#pragma unroll
                    for (int n = 0; n < 2; ++n) { const f32x4 x = *(const f32x4*)(XI + ro + bj * HALF + n * 4); const f32x4 z = x * ALPHA + acc[ai][bj][m][n] * s; acc[ai][bj][m][n] = z;
                        s1 += (z[0] + z[1]) + (z[2] + z[3]); s2 += (z[0] * z[0] + z[1] * z[1]) + (z[2] * z[2] + z[3] * z[3]); }
                s1 = rsum_fq(s1); s2 = rsum_fq(s2);
                if (fq == 0) { const unsigned long long bits = ((unsigned long long)__builtin_bit_cast(unsigned, s2) << 32) | (unsigned long long)__builtin_bit_cast(unsigned, s1);
                    __hip_atomic_store(xb0 + (size_t)(ai * HALF + m * 16) * 16 + u.pn * 4 + wc, bits, __ATOMIC_RELAXED, __HIP_MEMORY_SCOPE_AGENT); }
                if (m == 3) __builtin_amdgcn_sched_barrier(0); }
        asm volatile("s_waitcnt vmcnt(0)" ::: "memory");
        unsigned* cw = cnt + (u.pm * 2 + wr) * 64;
        if (fr == 0 && fq == 0) (void)__hip_atomic_fetch_add(cw, 1u, __ATOMIC_RELAXED, __HIP_MEMORY_SCOPE_AGENT);
        for (unsigned sp = 0; sp < (1u << 22); ++sp) { if (__hip_atomic_load(cw, __ATOMIC_RELAXED, __HIP_MEMORY_SCOPE_AGENT) >= target) break; __builtin_amdgcn_s_sleep(2); }
        asm volatile("s_waitcnt vmcnt(0)" ::: "memory");
#pragma unroll
        for (int ai = 0; ai < 2; ++ai)
#pragma unroll
            for (int m = 0; m < 4; ++m) { const unsigned long long* rp = xb0 + (size_t)(ai * HALF + m * 16) * 16 + fq * 4; float s1 = 0.f, s2 = 0.f;
#pragma unroll
                for (int k = 0; k < 4; ++k) { const unsigned long long bits = __hip_atomic_load(rp + k, __ATOMIC_RELAXED, __HIP_MEMORY_SCOPE_AGENT);
                    s1 += __builtin_bit_cast(float, (unsigned)(bits & 0xffffffffull)); s2 += __builtin_bit_cast(float, (unsigned)(bits >> 32)); }
                s1 = rsum_fq(s1); s2 = rsum_fq(s2);
                const float mean = s1 * (1.f / 1024.f), rstd = rsqrtf(fmaxf(s2 * (1.f / 1024.f) - mean * mean, 0.f) + 1e-5f);
                const size_t ro = (size_t)(row0 + ai * HALF + m * 16) * DM + c0;
#pragma unroll
                for (int bj = 0; bj < 2; ++bj) { const int c = c0 + bj * HALF; const f32x4 g0 = *(const f32x4*)(g + c), g1 = *(const f32x4*)(g + c + 4), b0 = *(const f32x4*)(bt + c), b1 = *(const f32x4*)(bt + c + 4);
                    const f32x4 y0 = (acc[ai][bj][m][0] - mean) * rstd * g0 + b0, y1 = (acc[ai][bj][m][1] - mean) * rstd * g1 + b1;
                    *(f32x4*)(XF + ro + bj * HALF) = y0; *(f32x4*)(XF + ro + bj * HALF + 4) = y1;
                    u32x4 w; w.x = pk2(y0[0], y0[1]); w.y = pk2(y0[2], y0[3]); w.z = pk2(y1[0], y1[1]); w.w = pk2(y1[2], y1[3]); *(u32x4*)(XB + ro + bj * HALF) = w; }
                if (m == 3) __builtin_amdgcn_sched_barrier(0); }
    }
};
struct EpiStore { static constexpr bool AFTER_DRAIN = false;
    bf16_t* O; long oBS1, oBS2; int ldc, split_shift; long split_stride; const float* rowscale; const float* colscale; const float* bias; int act, nB2, lay;
    __device__ __forceinline__ void operator()(const f32x4 (&acc)[2][2][4][2], const Unit& u, int wr, int wc, int fr, int fq) const {
        bf16_t* base = O + (size_t)(u.b / nB2) * oBS1 + (size_t)(u.b % nB2) * oBS2;
        const int row0 = u.pm * BM + wr * 64 + fr, c0 = u.pn * BM + wc * 32 + fq * 8;
#pragma unroll
        for (int ai = 0; ai < 2; ++ai)
#pragma unroll
            for (int m = 0; m < 4; ++m) { const int row = row0 + ai * HALF + m * 16; const float rs = rowscale ? rowscale[row] : 1.f;
#pragma unroll
                for (int bj = 0; bj < 2; ++bj) { const int c = c0 + bj * HALF; float v[8];
#pragma unroll
                    for (int j = 0; j < 4; ++j) { v[j] = acc[ai][bj][m][0][j]; v[4 + j] = acc[ai][bj][m][1][j]; }
                    if (bias) {
#pragma unroll
                        for (int j = 0; j < 8; ++j) v[j] += bias[c + j]; }
                    if (act) {
#pragma unroll
                        for (int j = 0; j < 8; ++j) { const float x = v[j], uu = 0.7978845608028654f * (x + 0.044715f * x * x * x); v[j] = x * sigm(2.f * uu); } }
#ifdef MK_SAN3
                    if (act) {
#pragma unroll
                        for (int j = 0; j < 8; ++j) if (!(fabsf(v[j]) < 1.0e6f)) v[j] = 0.f; }
#endif
                    if (colscale) {
#pragma unroll
                        for (int j = 0; j < 8; ++j) v[j] *= colscale[c + j]; }
                    u32x4 w; w.x = pk2(v[0] * rs, v[1] * rs); w.y = pk2(v[2] * rs, v[3] * rs); w.z = pk2(v[4] * rs, v[5] * rs); w.w = pk2(v[6] * rs, v[7] * rs);
                    const size_t co = split_shift ? (size_t)(c >> split_shift) * split_stride + (c & ((1 << split_shift) - 1)) : (size_t)c;
                    bf16_t* dst = base + (size_t)row * ldc + co;
                    if (lay == 1) dst = base + (size_t)((row >> 6) * 8 + (c >> 11)) * 131072 + vfrag_off(c & 2047, row & 63);
                    else if (lay == 2) dst = base + (size_t)((c >> 6) * 8 + (row >> 11)) * 131072 + kfrag_off(row & 2047, c & 63, 2);
                    *(u32x4*)dst = w; } }
    }
};
struct EpiMerge { static constexpr bool AFTER_DRAIN = false; const bf16_t* P; float* Z; bf16_t* MX; int unused_;
    __device__ __forceinline__ void operator()(f32x4 (&acc)[2][2][4][2], const Unit& u, int wr, int wc, int fr, int fq) const {
        const int row0 = u.pm * BM + wr * 64 + fr, c0 = u.pn * BM + wc * 32 + fq * 8; const int i = u.b;
#pragma unroll
        for (int ai = 0; ai < 2; ++ai)
#pragma unroll
            for (int m = 0; m < 4; ++m) { const int row = row0 + ai * HALF + m * 16;
#pragma unroll
                for (int bj = 0; bj < 2; ++bj) { const int c = c0 + bj * HALF;
                    const u32x4 gw = *(const u32x4*)(P + (size_t)row * PLD + PC_MG + i * DM + c);
                    float gi[8] = {sigm(bflo(gw.x)), sigm(bfhi(gw.x)), sigm(bflo(gw.y)), sigm(bfhi(gw.y)), sigm(bflo(gw.z)), sigm(bfhi(gw.z)), sigm(bflo(gw.w)), sigm(bfhi(gw.w))};
#pragma unroll
                    for (int j = 0; j < 8; ++j) gi[j] = fmaxf(gi[j], 1e-20f);
                    if (i < 2) { const u32x4 nw = *(const u32x4*)(P + (size_t)row * PLD + PC_MG + (i + 1) * DM + c);
                        const float gn[8] = {sigm(bflo(nw.x)), sigm(bfhi(nw.x)), sigm(bflo(nw.y)), sigm(bfhi(nw.y)), sigm(bflo(nw.z)), sigm(bfhi(nw.z)), sigm(bflo(nw.w)), sigm(bfhi(nw.w))};
#pragma unroll
                        for (int j = 0; j < 4; ++j) { acc[ai][bj][m][0][j] = acc[ai][bj][m][0][j] * (gi[j] / fmaxf(gn[j], 1e-20f)); acc[ai][bj][m][1][j] = acc[ai][bj][m][1][j] * (gi[4 + j] / fmaxf(gn[4 + j], 1e-20f)); } }
                    else { u32x4 w; w.x = pk2(acc[ai][bj][m][0][0] * gi[0], acc[ai][bj][m][0][1] * gi[1]); w.y = pk2(acc[ai][bj][m][0][2] * gi[2], acc[ai][bj][m][0][3] * gi[3]);
                        w.z = pk2(acc[ai][bj][m][1][0] * gi[4], acc[ai][bj][m][1][1] * gi[5]); w.w = pk2(acc[ai][bj][m][1][2] * gi[6], acc[ai][bj][m][1][3] * gi[7]);
                        *(u32x4*)(MX + (size_t)row * DM + c) = w; } } }
    }
};
struct EpiMlaQ { static constexpr bool AFTER_DRAIN = false; bf16_t* O; const float* rstd; const f32x2* rope;
    __device__ __forceinline__ void operator()(const f32x4 (&acc)[2][2][4][2], const Unit& u, int wr, int wc, int fr, int fq) const {
        const int row0 = u.pm * BM + wr * 64 + fr, c0 = u.pn * BM + wc * 32 + fq * 8;
        const float qs = 0.10206207261596577f * LOG2E;
#pragma unroll
        for (int ai = 0; ai < 2; ++ai)
#pragma unroll
            for (int m = 0; m < 4; ++m) { const int row = row0 + ai * HALF + m * 16; const float rs = rstd[row];
#pragma unroll
                for (int bj = 0; bj < 2; ++bj) { const int c = c0 + bj * HALF; const bool pe = (((u.pn * BM + bj * HALF + wc * 32) >> 5) % 3) == 2;
                    float v[8];
#pragma unroll
                    for (int j = 0; j < 4; ++j) { v[j] = acc[ai][bj][m][0][j] * rs; v[4 + j] = acc[ai][bj][m][1][j] * rs; }
                    if (pe) {
#pragma unroll
                        for (int j = 0; j < 8; ++j) { const float o = __shfl_xor(v[j], 32); const f32x2 cs = rope[(size_t)row * 16 + ((fq & 1) * 8 + j)];
                            v[j] = (fq < 2) ? (v[j] * cs.x - o * cs.y) : (v[j] * cs.x + o * cs.y); } }
                    u32x4 w; w.x = pk2(v[0] * qs, v[1] * qs); w.y = pk2(v[2] * qs, v[3] * qs); w.z = pk2(v[4] * qs, v[5] * qs); w.w = pk2(v[6] * qs, v[7] * qs);
                    *(u32x4*)(O + (size_t)row * 768 + c) = w; } }
    }
};
struct EpiXaSoft { static constexpr bool AFTER_DRAIN = true; bf16_t* O; long oBS1, oBS2; int ldc, nB2; float sc;
    __device__ __forceinline__ void fused(const f32x4 (&acc)[2][2][4][2], const Unit& u, int wr, int wc, int fr, int fq, LAS unsigned char* lds, int wid, int lane) const {
        LAS float* red = (LAS float*)lds;
        LAS float* red2 = red + 1024;
#pragma unroll
        for (int ai = 0; ai < 2; ++ai)
#pragma unroll
            for (int m = 0; m < 4; ++m) { float v = -3.0e38f;
#pragma unroll
                for (int bj = 0; bj < 2; ++bj)
#pragma unroll
                    for (int n = 0; n < 2; ++n)
#pragma unroll
                        for (int j = 0; j < 4; ++j) v = fmaxf(v, acc[ai][bj][m][n][j]);
                v = rmax_fq(v);
                if (fq == 0) red[(ai * HALF + wr * 64 + m * 16 + fr) * 4 + wc] = v; }
        __syncthreads();
#pragma unroll
        for (int ai = 0; ai < 2; ++ai)
#pragma unroll
            for (int m = 0; m < 4; ++m) { const int rr = ai * HALF + wr * 64 + m * 16 + fr; const f32x4 q = *(const LAS f32x4*)(red + rr * 4);
                const float mm = fmaxf(fmaxf(q[0], q[1]), fmaxf(q[2], q[3])); float s = 0.f;
#pragma unroll
                for (int bj = 0; bj < 2; ++bj)
#pragma unroll
                    for (int n = 0; n < 2; ++n)
#pragma unroll
                        for (int j = 0; j < 4; ++j) s += ex2((acc[ai][bj][m][n][j] - mm) * sc);
                s = rsum_fq(s);
                if (fq == 0) red2[rr * 4 + wc] = s; }
        __syncthreads();
        bf16_t* base = O + (size_t)(u.b / nB2) * oBS1 + (size_t)(u.b % nB2) * oBS2;
#pragma unroll
        for (int ai = 0; ai < 2; ++ai)
#pragma unroll
            for (int m = 0; m < 4; ++m) { const int rr = ai * HALF + wr * 64 + m * 16 + fr; const f32x4 q = *(const LAS f32x4*)(red + rr * 4), q2 = *(const LAS f32x4*)(red2 + rr * 4);
                const float mm = fmaxf(fmaxf(q[0], q[1]), fmaxf(q[2], q[3])); const float inv = 1.f / ((q2[0] + q2[1]) + (q2[2] + q2[3]));
#pragma unroll
                for (int bj = 0; bj < 2; ++bj) { const int c = bj * HALF + wc * 32 + fq * 8; float p[8];
#pragma unroll
                    for (int j = 0; j < 4; ++j) { p[j] = ex2((acc[ai][bj][m][0][j] - mm) * sc) * inv; p[4 + j] = ex2((acc[ai][bj][m][1][j] - mm) * sc) * inv; }
                    u32x4 w; w.x = pk2(p[0], p[1]); w.y = pk2(p[2], p[3]); w.z = pk2(p[4], p[5]); w.w = pk2(p[6], p[7]);
                    *(u32x4*)(base + (size_t)(u.pm * BM + rr) * ldc + u.pn * BM + c) = w; } }
        asm volatile("s_waitcnt vmcnt(0)" ::: "memory");
        __syncthreads();
    }
};
}

struct FAS { f32x4 o[4]; float m, l; };
__device__ __forceinline__ void fas_init(FAS& s) {
#pragma unroll
    for (int d = 0; d < 4; ++d) s.o[d] = (f32x4){0.f, 0.f, 0.f, 0.f};
    s.m = -1.0e30f; s.l = 0.f;
}
template <int NDC> struct FAFrag { bf16x8 kf[2][NDC], vf[4]; };
template <int NDC>
__device__ __forceinline__ void fa_load(FAFrag<NDC>& f, const bf16_t* const (&kb)[NDC], const int (&kcs)[NDC], const bf16_t* vt, int key0, int lane) {
    const int kb32 = key0 >> 5;
#pragma unroll
    for (int u = 0; u < 2; ++u)
#pragma unroll
        for (int dc = 0; dc < NDC; ++dc) f.kf[u][dc] = ld8(kb[dc] + (size_t)(kb32 * 2 + u) * kcs[dc] + lane * 8);
#pragma unroll
    for (int dt = 0; dt < 4; ++dt) f.vf[dt] = ld8(vt + (size_t)(kb32 * 4 + dt) * 512 + lane * 8);
}
template <int NCT, int NDC, class MaskF>
__device__ __forceinline__ void fa_compute(FAS (&st)[NCT], const bf16x8 (&qf)[NCT][NDC], const FAFrag<NDC>& f, int key0, float sscale, bool domask, const MaskF& valid, int fr, int fq) {
#pragma unroll
    for (int ct = 0; ct < NCT; ++ct) {
        f32x4 s[2];
#pragma unroll
        for (int u = 0; u < 2; ++u) { s[u] = (f32x4){0.f, 0.f, 0.f, 0.f};
#pragma unroll
            for (int dc = 0; dc < NDC; ++dc) s[u] = mfma16(f.kf[u][dc], qf[ct][dc], s[u]); }
        float sv[8]; bool ok[8];
#pragma unroll
        for (int e = 0; e < 8; ++e) { sv[e] = s[e >> 2][e & 3] * sscale; ok[e] = domask ? valid(ct, key0 + fq * 8 + e) : true; }
        float mx = -1.0e30f;
#pragma unroll
        for (int e = 0; e < 8; ++e) mx = fmaxf(mx, ok[e] ? sv[e] : -1.0e30f);
        mx = rmax_fq(mx);
        const float mn = fmaxf(st[ct].m, mx), alpha = ex2(st[ct].m - mn);
        float p[8], ls = 0.f;
#pragma unroll
        for (int e = 0; e < 8; ++e) { p[e] = ok[e] ? ex2(sv[e] - mn) : 0.f; ls += p[e]; }
        ls = rsum_fq(ls);
        st[ct].l = st[ct].l * alpha + ls; st[ct].m = mn;
        u32x4 pw; pw.x = pk2(p[0], p[1]); pw.y = pk2(p[2], p[3]); pw.z = pk2(p[4], p[5]); pw.w = pk2(p[6], p[7]);
        const bf16x8 pb = __builtin_bit_cast(bf16x8, pw);
#pragma unroll
        for (int dt = 0; dt < 4; ++dt) { st[ct].o[dt] = st[ct].o[dt] * alpha; st[ct].o[dt] = mfma16(f.vf[dt], pb, st[ct].o[dt]); }
    }
}
template <int NCT, int NDC, class MaskF>
__device__ __forceinline__ void fa_step(FAS (&st)[NCT], const bf16x8 (&qf)[NCT][NDC], const bf16_t* const (&kb)[NDC], const int (&kcs)[NDC], const bf16_t* vt,
                                        int key0, float sscale, bool domask, const MaskF& valid, int lane) {
    FAFrag<NDC> f; fa_load<NDC>(f, kb, kcs, vt, key0, lane); fa_compute<NCT, NDC>(st, qf, f, key0, sscale, domask, valid, lane & 15, lane >> 4);
}
template <int NCT, int NDC, class MaskF>
__device__ __forceinline__ void fa_step2(FAS (&st)[NCT], const bf16x8 (&qf)[NCT][NDC], const bf16_t* const (&kb)[NDC], const int (&kcs)[NDC], const bf16_t* vt,
                                         int key0, float sscale, bool domask0, bool domask1, const MaskF& valid, int lane) {
    FAFrag<NDC> f0, f1; fa_load<NDC>(f0, kb, kcs, vt, key0, lane); fa_load<NDC>(f1, kb, kcs, vt, key0 + 32, lane);
    fa_compute<NCT, NDC>(st, qf, f0, key0, sscale, domask0, valid, lane & 15, lane >> 4); fa_compute<NCT, NDC>(st, qf, f1, key0 + 32, sscale, domask1, valid, lane & 15, lane >> 4);
}

#define XB_TMO      128
#define XB_XCNT(j)  (256  + 64 * (j))
#define XB_XSUB(j)  (1280 + 64 * (j))
#define XB_XGEN(j)  (2304 + 64 * (j))
#define XB_TOP      3328
#define XB_TOPGEN   3392
#define XCD_BAR_WORDS 3456
#define XB_SPIN_CAP (1u << 20)
__device__ __forceinline__ unsigned xb_ld(unsigned* p)              { return __hip_atomic_load(p, __ATOMIC_RELAXED, __HIP_MEMORY_SCOPE_AGENT); }
__device__ __forceinline__ unsigned xb_add(unsigned* p, unsigned v) { return __hip_atomic_fetch_add(p, v, __ATOMIC_RELAXED, __HIP_MEMORY_SCOPE_AGENT); }
__device__ __forceinline__ unsigned xb_xcc_id() { return (unsigned)__builtin_amdgcn_s_getreg((3 << 11) | 20) & 0xFu; }
#define XB_SPIN(cond, bar) do { unsigned _sp = 0; while (cond) { __builtin_amdgcn_s_sleep(1); \
    if ((++_sp & 255u) == 0u) { if (xb_ld(&(bar)[XB_TMO])) break; if (_sp > XB_SPIN_CAP) { atomicAdd(&(bar)[XB_TMO], 1u); break; } } } } while (0)
__device__ __forceinline__ void xcd_barrier_complete(unsigned* bar, unsigned x, unsigned& nloc, unsigned& nx) {
    const unsigned G = gridDim.x;
    unsigned sum, cnt, mine, sp = 0u;
    for (;;) {
        sum = 0u; cnt = 0u; mine = 0u;
#pragma unroll
        for (unsigned j = 0; j < 16; ++j) { const unsigned c = xb_ld(&bar[XB_XCNT(j)]); sum += c; cnt += (c > 0u) ? 1u : 0u; mine = (j == x) ? c : mine; }
        if (sum == G) break;
        __builtin_amdgcn_s_sleep(1);
        if ((++sp & 255u) == 0u) { if (xb_ld(&bar[XB_TMO])) break; if (sp > XB_SPIN_CAP) { atomicAdd(&bar[XB_TMO], 1u); break; } }
    }
    nloc = mine > 0u ? mine : 1u; nx = cnt > 0u ? cnt : 1u;
}
__device__ __forceinline__ void xcd_barrier(unsigned* bar, volatile LAS unsigned* st) {
    asm volatile("s_waitcnt vmcnt(0)" ::: "memory");
    __syncthreads();
    if (threadIdx.x == 0) {
        const unsigned x = xb_xcc_id();
        __builtin_amdgcn_s_waitcnt(0);
        unsigned nloc = st[0], nx = st[1];
        if (nloc == 0u) { xcd_barrier_complete(bar, x, nloc, nx); st[0] = nloc; st[1] = nx; }
        const unsigned old = xb_add(&bar[XB_XSUB(x)], 1u);
        const unsigned gen = old / nloc;
        if (old + 1u == (gen + 1u) * nloc) {
            __builtin_amdgcn_fence(__ATOMIC_RELEASE, "agent");
            asm volatile("s_waitcnt vmcnt(0)" ::: "memory");
            const unsigned og = xb_add(&bar[XB_TOP], 1u);
            const unsigned tg = og / nx;
            if (og + 1u == (tg + 1u) * nx) xb_add(&bar[XB_TOPGEN], 1u);
            else XB_SPIN(xb_ld(&bar[XB_TOPGEN]) == tg, bar);
            __builtin_amdgcn_fence(__ATOMIC_ACQUIRE, "agent");
            xb_add(&bar[XB_XGEN(x)], 1u);
            asm volatile("s_waitcnt vmcnt(0)" ::: "memory");
        } else {
            XB_SPIN(xb_ld(&bar[XB_XGEN(x)]) == gen, bar);
            __builtin_amdgcn_fence(__ATOMIC_ACQUIRE, "agent");
            asm volatile("s_waitcnt vmcnt(0)" ::: "memory");
        }
    }
    __syncthreads();
}

struct Args { const void* in[24]; float* out; unsigned char* ws; int ph_lo, ph_hi; };
__device__ __forceinline__ unsigned char* wsp(const Args& a) { unsigned char* p = a.ws; asm volatile("" : "+s"(p)); return p; }
__device__ __forceinline__ const void* inp(const Args& a, int i) { const void* p = a.in[i]; asm volatile("" : "+s"(p)); return p; }
__device__ __forceinline__ float* outp(const Args& a) { float* p = a.out; asm volatile("" : "+s"(p)); return p; }

__device__ __forceinline__ void phase_init(const Args& a) {
    unsigned char* ws = wsp(a);
    const int gtid = bidx() * 512 + tidx(), GT = gdim() * 512;
    const int* pos = (const int*)inp(a, 2);
    f32x2* ropeM = (f32x2*)(ws + WS_ROPEM); f32x2* ropeN = (f32x2*)(ws + WS_ROPEN);
    for (int idx = gtid; idx < T * 16; idx += GT) { const int tok = idx >> 4, i = idx & 15; const float p = (float)pos[tok];
        { const float inv = powf(500000.0f, -(float)i / 16.0f), ang = p * inv; ropeM[idx] = (f32x2){cosf(ang), sinf(ang)}; }
        if (i < 8) { const float inv = powf(500000.0f, -(float)i / 8.0f), ang = p * inv; ropeN[tok * 8 + i] = (f32x2){cosf(ang), sinf(ang)}; } }
    if (gtid < 512) { const float* lg = (const float*)inp(a, 12); float* lb = (float*)(ws + WS_LB);
        const float l0 = lg[gtid], l1 = lg[512 + gtid], l2 = lg[1024 + gtid], l3 = lg[1536 + gtid], m = fmaxf(fmaxf(l0, l1), fmaxf(l2, l3));
        const float e0 = expf(l0 - m), e1 = expf(l1 - m), e2 = expf(l2 - m), e3 = expf(l3 - m), inv = 1.f / (e0 + e1 + e2 + e3);
        const float p0 = e0 * inv, p1 = e1 * inv, p2 = e2 * inv, p3 = e3 * inv; const float c1 = p0 + p1, c2 = c1 + p2, c3 = c2 + p3;
        lb[gtid] = 0.f; lb[512 + gtid] = c1 - p0; lb[1024 + gtid] = c2 - p0; lb[1536 + gtid] = c3 - p0; }
    { const f32x4* x = (const f32x4*)inp(a, 0); f32x4* xf = (f32x4*)outp(a); u32x2* xb = (u32x2*)(ws + WS_XB);
      for (int i = gtid; i < T * DM / 4; i += GT) { const f32x4 v = x[i]; u32x2 w; w.x = pk2(v[0], v[1]); w.y = pk2(v[2], v[3]); xb[i] = w; } (void)xf; }
    { const f32x4* x = (const f32x4*)inp(a, 1); u32x2* mb = (u32x2*)(ws + WS_MEMB);
      for (int i = gtid; i < 2048 * DM / 4; i += GT) { const f32x4 v = x[i]; u32x2 w; w.x = pk2(v[0], v[1]); w.y = pk2(v[2], v[3]); mb[i] = w; } }
    { unsigned* z = (unsigned*)(ws + WS_KCG + 8 * MiB); for (int i = gtid; i < 16384; i += GT) z[i] = 0u; }
    if (bidx() == 0) { unsigned* bz = (unsigned*)(ws + WS_BAR); for (int i = tidx(); i < 12288 + 256; i += 512) bz[i] = 0u; }
}

constexpr int NSEG = 36;
__device__ const int SEGT[NSEG][10] = {
    {5, 2 * 1024 * 2816, 0, 2816, 0, 2816, 1024, W_UP1, 1, -1}, {6, 2 * 1024 * 2816, 0, 2816, 0, 2816, 1024, W_UP1, 2, -1},
    {5, 2 * 1024 * 2816, 1024 * 2816, 2816, 0, 2816, 1024, W_UP2, 1, -1}, {6, 2 * 1024 * 2816, 1024 * 2816, 2816, 0, 2816, 1024, W_UP2, 2, -1},
    {7, 2 * 2816 * 1024, 0, 1024, 0, 1024, 2816, W_DN1, 0, -1}, {7, 2 * 2816 * 1024, 2816 * 1024, 1024, 0, 1024, 2816, W_DN2, 0, -1},
    {8, 1024 * 7096, 0, 7096, 0, 512, 1024, W_IN + 0 * 1024, 0, -1},
    {8, 1024 * 7096, 0, 7096, 512, 128, 1024, W_IN + 6656 * 1024, 0, -1},
    {8, 1024 * 7096, 0, 7096, 640, 128, 1024, W_IN + 6784 * 1024, 0, -1},
    {8, 1024 * 7096, 0, 7096, 768, 128, 1024, W_IN + 512 * 1024, 0, -1},
    {8, 1024 * 7096, 0, 7096, 896, 128, 1024, W_IN + 6912 * 1024, 0, -1},
    {8, 1024 * 7096, 0, 7096, 1024, 128, 1024, W_IN + 640 * 1024, 0, -1},
    {8, 1024 * 7096, 0, 7096, 1152, 128, 1024, W_IN + 7040 * 1024, 0, -1},
    {8, 1024 * 7096, 0, 7096, 1280, 24, 1024, W_IN + 768 * 1024, 0, -1},
    {8, 1024 * 7096, 0, 7096, 1304, 512, 1024, W_IN + 1472 * 1024, 0, -1},
    {8, 1024 * 7096, 0, 7096, 1816, 512, 1024, W_IN + 1984 * 1024, 0, -1},
    {8, 1024 * 7096, 0, 7096, 2328, 512, 1024, W_IN + 2496 * 1024, 0, -1},
    {8, 1024 * 7096, 0, 7096, 2840, 512, 1024, W_IN + 3008 * 1024, 0, -1},
    {8, 1024 * 7096, 0, 7096, 3352, 384, 1024, W_IN + 800 * 1024, 0, -1},
    {8, 1024 * 7096, 0, 7096, 3736, 256, 1024, W_IN + 1184 * 1024, 0, -1},
    {8, 1024 * 7096, 0, 7096, 3992, 32, 1024, W_IN + 1440 * 1024, 0, -1},
    {8, 1024 * 7096, 0, 7096, 4024, 3072, 1024, W_IN + 3520 * 1024, 0, -1},
    {0, 0, 0, 0, 0, 8, 1024, W_IN + 792 * 1024, 3, -1}, {0, 0, 0, 0, 0, 64, 1024, W_IN + 6592 * 1024, 3, -1},
    {10, 2 * 2048 * 256, 0, 256, 0, 256, 2048, W_CMP, 0, -1}, {10, 2 * 2048 * 256, 2048 * 256, 256, 0, 256, 2048, W_CMP + 256 * 2048, 0, -1},
    {15, 384 * 768, 0, 768, 0, 768, 384, W_UQ, 0, 14},
    {17, 256 * 1024, 0, 1024, 0, 1024, 256, W_KN, 4, 16},
    {18, 3 * 512 * 1024, 0, 1024, 0, 1024, 512, W_BR, 0, -1}, {18, 3 * 512 * 1024, 512 * 1024, 1024, 0, 1024, 512, W_BR + 1024 * 512, 0, -1}, {18, 3 * 512 * 1024, 2 * 512 * 1024, 1024, 0, 1024, 512, W_BR + 2 * 1024 * 512, 0, -1},
    {19, 1048576, 0, 1024, 0, 1024, 1024, W_OUT, 0, -1}, {20, 1048576, 0, 1024, 0, 1024, 1024, W_XQ, 0, -1}, {23, 1048576, 0, 1024, 0, 1024, 1024, W_XO, 0, -1},
    {21, 1048576, 0, 1024, 0, 1024, 1024, W_XK, 0, -1}, {22, 1048576, 0, 1024, 0, 1024, 1024, W_XV, 0, -1},
};
__device__ __forceinline__ void phase_conv(const Args& a, int l, LAS unsigned char* lds) {
    LAS float* tile = (LAS float*)lds;
    bf16_t* W = (bf16_t*)(wsp(a) + WS_W);
    const int tid = tidx(), G = gdim();
    int rot = 0;
    for (int s = 0; s < NSEG; ++s) {
        const int src = SEGT[s][0], lstr = SEGT[s][1], extra = SEGT[s][2], ld = SEGT[s][3], col0 = SEGT[s][4], ncols = SEGT[s][5], K = SEGT[s][6], dsto = SEGT[s][7], mode = SEGT[s][8], ksrc = SEGT[s][9];
        const int ntn = (ncols + 127) >> 7, ntk = K >> 6, items = ntn * ntk;
        const float* S = (const float*)inp(a, src) + (size_t)l * lstr + extra;
        const float* KS = ksrc >= 0 ? (const float*)inp(a, ksrc) + (size_t)l * K : nullptr;
        bf16_t* D = W + dsto;
        int first = bidx() - rot; if (first < 0) first += G;
        const int kq = tid >> 5, n4 = (tid & 31) * 4;
        f32x4 pv[4]; float pks[4];
#pragma unroll
        for (int i = 0; i < 4; ++i) { pv[i] = (f32x4){0.f, 0.f, 0.f, 0.f}; pks[i] = 1.f; }
        if (first < items && mode != 3) { const int tn = first / ntk, tk = first % ntk, n0 = tn * 128, k0 = tk * 64;
#pragma unroll
            for (int i = 0; i < 4; ++i) { const int k = i * 16 + kq; if (n0 + n4 < ncols) { pv[i] = *(const f32x4*)(S + (size_t)(k0 + k) * ld + col0 + n0 + n4); if (KS) pks[i] = KS[k0 + k]; } } }
        for (int it = first; it < items; it += G) {
            const int tn = it / ntk, tk = it % ntk, n0 = tn * 128, k0 = tk * 64;
            if (mode != 3) {
#pragma unroll
                for (int i = 0; i < 4; ++i) { const int k = i * 16 + kq; const f32x4 v = pv[i] * pks[i];
                    tile[k * 129 + n4] = v[0]; tile[k * 129 + n4 + 1] = v[1]; tile[k * 129 + n4 + 2] = v[2]; tile[k * 129 + n4 + 3] = v[3]; }
            }
            __syncthreads();
            { const int nit = it + G;
              if (nit < items && mode != 3) { const int tn2 = nit / ntk, tk2 = nit % ntk, n02 = tn2 * 128, k02 = tk2 * 64;
#pragma unroll
                  for (int i = 0; i < 4; ++i) { const int k = i * 16 + kq; pv[i] = (f32x4){0.f, 0.f, 0.f, 0.f}; pks[i] = 1.f;
                      if (n02 + n4 < ncols) { pv[i] = *(const f32x4*)(S + (size_t)(k02 + k) * ld + col0 + n02 + n4); if (KS) pks[i] = KS[k02 + k]; } } } }
            { const int n = tid >> 2, kc = (tid & 3) * 16, nn = n0 + n;
              if (nn < ncols) {
                  int dr = nn;
                  if (mode == 1) dr = (nn >> 2) * 8 + (nn & 3); else if (mode == 2) dr = (nn >> 2) * 8 + 4 + (nn & 3); else if (mode == 4) dr = ((nn & 64) ? 512 : 0) + (nn >> 7) * 64 + (nn & 63);
                  u32x4 w0 = (u32x4){0u, 0u, 0u, 0u}, w1 = (u32x4){0u, 0u, 0u, 0u};
                  if (mode != 3) { const LAS float* tp = tile + kc * 129 + n;
                      w0.x = pk2(tp[0], tp[129]); w0.y = pk2(tp[2 * 129], tp[3 * 129]); w0.z = pk2(tp[4 * 129], tp[5 * 129]); w0.w = pk2(tp[6 * 129], tp[7 * 129]);
                      w1.x = pk2(tp[8 * 129], tp[9 * 129]); w1.y = pk2(tp[10 * 129], tp[11 * 129]); w1.z = pk2(tp[12 * 129], tp[13 * 129]); w1.w = pk2(tp[14 * 129], tp[15 * 129]); }
                  bf16_t* dp = D + (size_t)dr * K + k0 + kc; *(u32x4*)dp = w0; *(u32x4*)(dp + 8) = w1; } }
            __syncthreads();
        }
        rot = (rot + items) % G;
    }
}

__device__ __forceinline__ void phase_ln(const Args& a, int l, int j, bool do_bias) {
    const int lane = tidx() & 63, gw = bidx() * 8 + (tidx() >> 6), GW = gdim() * 8;
    const float* g = (const float*)inp(a, 3) + (size_t)(l * 4 + j) * DM; const float* bb = (const float*)inp(a, 4) + (size_t)(l * 4 + j) * DM;
    const float* Z = (const float*)(wsp(a) + WS_Z); float* XF = outp(a); bf16_t* XB = (bf16_t*)(wsp(a) + WS_XB);
    f32x4 gv[4], bv[4];
#pragma unroll
    for (int i = 0; i < 4; ++i) { gv[i] = *(const f32x4*)(g + i * 256 + lane * 4); bv[i] = *(const f32x4*)(bb + i * 256 + lane * 4); }
    for (int row = gw; row < T; row += GW) {
        f32x4 v[4]; float s = 0.f;
#pragma unroll
        for (int i = 0; i < 4; ++i) { v[i] = *(const f32x4*)(Z + (size_t)row * DM + i * 256 + lane * 4); s += (v[i][0] + v[i][1]) + (v[i][2] + v[i][3]); }
        const float mu = wave_sum(s) * (1.f / 1024.f); float q = 0.f;
#pragma unroll
        for (int i = 0; i < 4; ++i) { const f32x4 d = v[i] - mu; q += (d[0] * d[0] + d[1] * d[1]) + (d[2] * d[2] + d[3] * d[3]); }
        const float rstd = rsqrtf(wave_sum(q) * (1.f / 1024.f) + 1e-5f);
#pragma unroll
        for (int i = 0; i < 4; ++i) { const f32x4 o = (v[i] - mu) * rstd * gv[i] + bv[i]; *(f32x4*)(XF + (size_t)row * DM + i * 256 + lane * 4) = o;
            u32x2 w; w.x = pk2(o[0], o[1]); w.y = pk2(o[2], o[3]); *(u32x2*)(XB + (size_t)row * DM + i * 256 + lane * 4) = w; }
    }
    if (do_bias && gw < 512) {
        const int which = gw >> 8, n = gw & 255; const bf16_t* w = (const bf16_t*)(wsp(a) + WS_W) + W_CMP + (size_t)(which * 256 + n) * 2048;
        const float* pe = (const float*)inp(a, 9) + (size_t)(l * 2 + which) * 2048; float s = 0.f;
#pragma unroll
        for (int i = 0; i < 4; ++i) { const int k = i * 512 + lane * 8; const u32x4 ww = *(const u32x4*)(w + k); const f32x4 p0 = *(const f32x4*)(pe + k), p1 = *(const f32x4*)(pe + k + 4);
            s += bflo(ww.x) * p0[0] + bfhi(ww.x) * p0[1] + bflo(ww.y) * p0[2] + bfhi(ww.y) * p0[3] + bflo(ww.z) * p1[0] + bfhi(ww.z) * p1[1] + bflo(ww.w) * p1[2] + bfhi(ww.w) * p1[3]; }
        s = wave_sum(s); if (lane == 0) ((float*)(wsp(a) + WS_CBIAS))[gw] = s;
    }
}

__device__ __forceinline__ void s1_tokens(const Args& a) {
    const int lane = tidx() & 63, gw = bidx() * 8 + (tidx() >> 6), GW = gdim() * 8;
    bf16_t* P = (bf16_t*)(wsp(a) + WS_PROJ); const f32x2* ropeM = (const f32x2*)(wsp(a) + WS_ROPEM); const f32x2* ropeN = (const f32x2*)(wsp(a) + WS_ROPEN);
    bf16_t* kpe = (bf16_t*)(wsp(a) + WS_KPE); bf16_t* kfn = (bf16_t*)(wsp(a) + WS_KFN); float* rsq = (float*)(wsp(a) + WS_RSQ); float* rskv = (float*)(wsp(a) + WS_RSKV);
    for (int tok = gw; tok < T; tok += GW) {
        bf16_t* row = P + (size_t)tok * PLD;
        const int b = tok >> 11, sq = tok & 2047;
        { const int l5 = lane & 31, tg = l5 >> 3, ch = l5 & 7;
          u32x4 v = *(const u32x4*)(row + PC_KS + tg * 64 + ch * 8); u32x4 par;
          par.x = (unsigned)__shfl_xor((int)v.x, 1); par.y = (unsigned)__shfl_xor((int)v.y, 1); par.z = (unsigned)__shfl_xor((int)v.z, 1); par.w = (unsigned)__shfl_xor((int)v.w, 1);
          if (ch < 2) { const float sgn = (ch == 0) ? -1.f : 1.f; const unsigned ow[4] = {v.x, v.y, v.z, v.w}, pw[4] = {par.x, par.y, par.z, par.w}; unsigned rw[4];
#pragma unroll
              for (int j = 0; j < 4; ++j) { const f32x2 c0 = ropeN[tok * 8 + 2 * j], c1 = ropeN[tok * 8 + 2 * j + 1];
                  rw[j] = pk2(bflo(ow[j]) * c0.x + sgn * bflo(pw[j]) * c0.y, bfhi(ow[j]) * c1.x + sgn * bfhi(pw[j]) * c1.y); }
              v = (u32x4){rw[0], rw[1], rw[2], rw[3]}; }
          if (lane < 32) *(u32x4*)(kfn + (size_t)(((tg >> 1) * 8 + b) * 2 + (tg & 1)) * 131072 + kfrag_off(sq, ch * 8, 2)) = v; }
        if (lane >= 32 && lane < 48) { const int i = lane - 32; const float x1 = bf2f(row[PC_KR + i]), x2 = bf2f(row[PC_KR + 16 + i]); const f32x2 cs = ropeM[tok * 16 + i];
            const unsigned w = pk2(x1 * cs.x - x2 * cs.y, x2 * cs.x + x1 * cs.y); kpe[(size_t)b * 65536 + kfrag_off(sq, i, 1)] = (bf16_t)(w & 0xffffu); kpe[(size_t)b * 65536 + kfrag_off(sq, 16 + i, 1)] = (bf16_t)(w >> 16); }
        float s1 = 0.f, s2 = 0.f;
#pragma unroll
        for (int i = 0; i < 6; ++i) { const float v = bf2f(row[PC_CQ + i * 64 + lane]); s1 += v * v; }
#pragma unroll
        for (int i = 0; i < 4; ++i) { const float v = bf2f(row[PC_CKV + i * 64 + lane]); s2 += v * v; }
        s1 = wave_sum(s1); s2 = wave_sum(s2);
        if (lane == 0) { rsq[tok] = rsqrtf(s1 * (1.f / 384.f) + 1e-6f); rskv[tok] = rsqrtf(s2 * (1.f / 256.f) + 1e-6f); }
    }
}

__device__ __forceinline__ void hgrn_stage1(const Args& a, int l, int item, LAS unsigned char* lds) {
    constexpr int RS = 132, AS = 68, TS = 72;
    LAS float* q = (LAS float*)lds; LAS float* bb = q + 64 * RS; LAS float* kk = bb + 64 * RS; LAS float* Am = kk + 64 * RS; LAS float* X = Am + 64 * AS;
    LAS bf16_t* kT = (LAS bf16_t*)q;
    LAS bf16_t* vT = (LAS bf16_t*)X;
    LAS float* tot = X;
    const int tid = tidx(), lane = tid & 63, w = tid >> 6, fr = lane & 15, fq = lane >> 4; const int b = item >> 7, h = (item >> 5) & 3, c = item & 31; const int tok0 = b * SEQ + c * 64;
    bf16_t* P = (bf16_t*)(wsp(a) + WS_PROJ); const float* lbp = (const float*)(wsp(a) + WS_LB) + l * 512 + h * 128;
    for (int idx = tid; idx < 1024; idx += 512) { const int t = idx >> 4, d0 = (idx & 15) * 8; const bf16_t* row = P + (size_t)(tok0 + t) * PLD + h * 128 + d0;
        const u32x4 qw = *(const u32x4*)(row + PC_BQ), zw = *(const u32x4*)(row + PC_BF); const f32x4 l0 = *(const f32x4*)(lbp + d0), l1 = *(const f32x4*)(lbp + d0 + 4);
        const float qv[8] = {bflo(qw.x), bfhi(qw.x), bflo(qw.y), bfhi(qw.y), bflo(qw.z), bfhi(qw.z), bflo(qw.w), bfhi(qw.w)};
        const float zv[8] = {bflo(zw.x), bfhi(zw.x), bflo(zw.y), bfhi(zw.y), bflo(zw.z), bfhi(zw.z), bflo(zw.w), bfhi(zw.w)};
        const float lb[8] = {l0[0], l0[1], l0[2], l0[3], l1[0], l1[1], l1[2], l1[3]};
#pragma unroll
        for (int j = 0; j < 8; ++j) { const float en = ex2(-fminf(fmaxf(zv[j], -80.f), 80.f) * LOG2E), sg = rcpf(1.f + en), sgn = en * sg; const float f = lb[j] + (1.f - lb[j]) * sg;
            q[t * RS + d0 + j] = qv[j]; bb[t * RS + d0 + j] = __log2f(fmaxf(f, 1e-20f)); kk[t * RS + d0 + j] = (1.f - lb[j]) * sgn; } }
    __syncthreads();
    {
        const int d = tid & 127, p = tid >> 7; float vals[16]; float run = 0.f;
#pragma unroll
        for (int i = 0; i < 16; ++i) { run += bb[(16 * p + i) * RS + d]; vals[i] = run; }
        tot[p * 128 + d] = run;
        __syncthreads();
        float off = 0.f;
#pragma unroll
        for (int pp = 0; pp < 3; ++pp) off += (pp < p) ? tot[pp * 128 + d] : 0.f;
#pragma unroll
        for (int i = 0; i < 16; ++i) bb[(16 * p + i) * RS + d] = vals[i] + off;
    }
    __syncthreads();
    {
        const int I = tid >> 7, p = tid & 127, tr = 16 * I + (p >> 3), s0 = (p & 7) * 2, sr = 16 * I + s0; float a0 = 0.f, a1 = 0.f;
        for (int d = 0; d < 128; d += 4) { const f32x4 qt = *(const LAS f32x4*)(q + tr * RS + d), bt = *(const LAS f32x4*)(bb + tr * RS + d);
            const f32x4 k0 = *(const LAS f32x4*)(kk + sr * RS + d), b0 = *(const LAS f32x4*)(bb + sr * RS + d), k1 = *(const LAS f32x4*)(kk + (sr + 1) * RS + d), b1 = *(const LAS f32x4*)(bb + (sr + 1) * RS + d);
#pragma unroll
            for (int j = 0; j < 4; ++j) { a0 += qt[j] * k0[j] * ex2(fminf(bt[j] - b0[j], 0.f)); a1 += qt[j] * k1[j] * ex2(fminf(bt[j] - b1[j], 0.f)); } }
        Am[tr * AS + sr] = (s0 <= (p >> 3)) ? a0 : 0.f; Am[tr * AS + sr + 1] = (s0 + 1 <= (p >> 3)) ? a1 : 0.f;
        for (int idx = tid; idx < 1536; idx += 512) { const int blk = idx >> 8, e = idx & 255; const int bi = blk < 3 ? 0 : (blk < 5 ? 1 : 2), bj = blk < 3 ? blk + 1 : (blk < 5 ? blk - 1 : 3);
            Am[(16 * bi + (e >> 4)) * AS + 16 * bj + (e & 15)] = 0.f; }
    }
#pragma unroll 1
    for (int I = 1; I < 4; ++I) {
        __syncthreads();
        { const int nrows = 16 * I + 16; const LAS float* rr = bb + (16 * I - 1) * RS;
          for (int idx = tid; idx < nrows * 128; idx += 512) { const int row = idx >> 7, d = idx & 127; const float r = rr[d];
              if (row < 16 * I) X[row * RS + d] = kk[row * RS + d] * ex2(fminf(r - bb[row * RS + d], 0.f));
              else X[(48 + row - 16 * I) * RS + d] = q[row * RS + d] * ex2(fminf(bb[row * RS + d] - r, 0.f)); } }
        __syncthreads();
        { const int tp = tid & 15, sg = tid >> 4;
          for (int s = sg; s < 16 * I; s += 32) { float acc = 0.f;
              for (int d = 0; d < 128; d += 4) { const f32x4 x = *(const LAS f32x4*)(X + (48 + tp) * RS + d), y = *(const LAS f32x4*)(X + s * RS + d); acc += (x[0] * y[0] + x[1] * y[1]) + (x[2] * y[2] + x[3] * y[3]); }
              Am[(16 * I + tp) * AS + s] = acc; } }
    }
    __syncthreads();
    for (int idx = tid; idx < 1024; idx += 512) { const int t = idx >> 4, d0 = (idx & 15) * 8; float qd[8];
        const u32x4 vw = *(const u32x4*)(P + (size_t)(tok0 + t) * PLD + PC_BI + h * 128 + d0);
#pragma unroll
        for (int j = 0; j < 8; ++j) qd[j] = q[t * RS + d0 + j] * ex2(bb[t * RS + d0 + j]);
        u32x4 wv; wv.x = pk2(qd[0], qd[1]); wv.y = pk2(qd[2], qd[3]); wv.z = pk2(qd[4], qd[5]); wv.w = pk2(qd[6], qd[7]);
        *(u32x4*)(P + (size_t)(tok0 + t) * PLD + PC_BQ + h * 128 + d0) = wv;
        vT[(d0 + 0) * TS + t] = (bf16_t)(vw.x & 0xffffu); vT[(d0 + 1) * TS + t] = (bf16_t)(vw.x >> 16); vT[(d0 + 2) * TS + t] = (bf16_t)(vw.y & 0xffffu); vT[(d0 + 3) * TS + t] = (bf16_t)(vw.y >> 16);
        vT[(d0 + 4) * TS + t] = (bf16_t)(vw.z & 0xffffu); vT[(d0 + 5) * TS + t] = (bf16_t)(vw.z >> 16); vT[(d0 + 6) * TS + t] = (bf16_t)(vw.w & 0xffffu); vT[(d0 + 7) * TS + t] = (bf16_t)(vw.w >> 16); }
    if (tid < 128) ((float*)(wsp(a) + WS_DEC))[(size_t)item * 128 + tid] = ex2(bb[63 * RS + tid]);
    __syncthreads();
    for (int idx = tid; idx < 8192; idx += 512) { const int t = idx >> 7, d = idx & 127;
        const float kd = kk[t * RS + d] * ex2(bb[63 * RS + d] - bb[t * RS + d]);
        kT[d * TS + t] = (bf16_t)(pk2(kd, 0.f) & 0xffffu); }
    __syncthreads();
    {
        f32x4 acc[8];
#pragma unroll
        for (int et = 0; et < 8; ++et) acc[et] = (f32x4){0.f, 0.f, 0.f, 0.f};
#pragma unroll
        for (int ks = 0; ks < 2; ++ks) { const bf16x8 af = *(const LAS bf16x8*)(kT + (w * 16 + fr) * TS + ks * 32 + fq * 8);
#pragma unroll
            for (int et = 0; et < 8; ++et) acc[et] = mfma16(af, *(const LAS bf16x8*)(vT + (et * 16 + fr) * TS + ks * 32 + fq * 8), acc[et]); }
        float* st = (float*)(wsp(a) + WS_Z) + (size_t)item * 16384 + (size_t)fr * 128 + w * 16 + fq * 4;
#pragma unroll
        for (int et = 0; et < 8; ++et) *(f32x4*)(st + (size_t)et * 16 * 128) = acc[et];
    }
    {
        f32x4 acc[4];
#pragma unroll
        for (int tt = 0; tt < 4; ++tt) acc[tt] = (f32x4){0.f, 0.f, 0.f, 0.f};
#pragma unroll
        for (int ks = 0; ks < 2; ++ks) { const bf16x8 af = *(const LAS bf16x8*)(vT + (w * 16 + fr) * TS + ks * 32 + fq * 8);
#pragma unroll
            for (int tt = 0; tt < 4; ++tt) { const LAS float* ap = Am + (tt * 16 + fr) * AS + ks * 32 + fq * 8; const f32x4 x0 = *(const LAS f32x4*)ap, x1 = *(const LAS f32x4*)(ap + 4);
                u32x4 bw; bw.x = pk2(x0[0], x0[1]); bw.y = pk2(x0[2], x0[3]); bw.z = pk2(x1[0], x1[1]); bw.w = pk2(x1[2], x1[3]);
                acc[tt] = mfma16(af, __builtin_bit_cast(bf16x8, bw), acc[tt]); } }
#pragma unroll
        for (int tt = 0; tt < 4; ++tt) { u32x2 wv; wv.x = pk2(acc[tt][0], acc[tt][1]); wv.y = pk2(acc[tt][2], acc[tt][3]);
            *(u32x2*)(P + (size_t)(tok0 + tt * 16 + fr) * PLD + PC_BF + h * 128 + w * 16 + fq * 4) = wv; }
    }
    __syncthreads();
}
__device__ __forceinline__ void hgrn_scan(const Args& a) {
    const int gtid = bidx() * 512 + tidx(), GT = gdim() * 512; float* st = (float*)(wsp(a) + WS_Z); const float* dec = (const float*)(wsp(a) + WS_DEC);
    for (int idx = gtid; idx < 32 * 16384; idx += GT) { const int bh = idx >> 14, de = idx & 16383, d = de & 127;
        float kv[32], dc[32];
#pragma unroll
        for (int c = 0; c < 32; ++c) { const size_t ch = (size_t)bh * 32 + c; kv[c] = st[ch * 16384 + de]; dc[c] = dec[ch * 128 + d]; }
        float S = 0.f;
#pragma unroll
        for (int c = 0; c < 32; ++c) { const size_t ch = (size_t)bh * 32 + c; st[ch * 16384 + de] = S; S = dc[c] * S + kv[c]; } }
}
__device__ __forceinline__ void hgrn_stage3(const Args& a, int l, int item, int nitem, f32x4 (&sv)[8], LAS unsigned char* lds) {
    constexpr int TS2 = 136;
    LAS bf16_t* ST = (LAS bf16_t*)lds; LAS float* red = (LAS float*)(lds + 128 * TS2 * 2);
    const int tid = tidx(), lane = tid & 63, w = tid >> 6, fr = lane & 15, fq = lane >> 4; const int b = item >> 7, h = (item >> 5) & 3, c = item & 31; const int tok0 = b * SEQ + c * 64;
    const bf16_t* P = (const bf16_t*)(wsp(a) + WS_PROJ); const float* st = (const float*)(wsp(a) + WS_Z) + (size_t)item * 16384;
    bf16x8 qf[4][4];
#pragma unroll
    for (int ks = 0; ks < 4; ++ks)
#pragma unroll
        for (int tt = 0; tt < 4; ++tt) qf[ks][tt] = ld8(P + (size_t)(tok0 + tt * 16 + fr) * PLD + PC_BQ + h * 128 + ks * 32 + fq * 8);
    u32x2 iwv[4], gwv[4];
#pragma unroll
    for (int tt = 0; tt < 4; ++tt) { const bf16_t* row = P + (size_t)(tok0 + tt * 16 + fr) * PLD + h * 128 + w * 16 + fq * 4; iwv[tt] = *(const u32x2*)(row + PC_BF); gwv[tt] = *(const u32x2*)(row + PC_BG); }
#pragma unroll
    for (int i = 0; i < 8; ++i) { const int ii = tid + i * 512; u32x2 p; p.x = pk2(sv[i][0], sv[i][1]); p.y = pk2(sv[i][2], sv[i][3]); *(LAS u32x2*)(ST + (ii >> 5) * TS2 + (ii & 31) * 4) = p; }
    if (nitem < 1024) { const float* st2 = (const float*)(wsp(a) + WS_Z) + (size_t)nitem * 16384;
#pragma unroll
        for (int i = 0; i < 8; ++i) { const int ii = tid + i * 512; sv[i] = *(const f32x4*)(st2 + (ii >> 5) * 128 + (ii & 31) * 4); } }
    __syncthreads();
    f32x4 acc[4];
#pragma unroll
    for (int tt = 0; tt < 4; ++tt) acc[tt] = (f32x4){0.f, 0.f, 0.f, 0.f};
#pragma unroll
    for (int ks = 0; ks < 4; ++ks) { const bf16x8 af = *(const LAS bf16x8*)(ST + (w * 16 + fr) * TS2 + ks * 32 + fq * 8);
#pragma unroll
        for (int tt = 0; tt < 4; ++tt) acc[tt] = mfma16(af, qf[ks][tt], acc[tt]); }
    float o[4][4];
#pragma unroll
    for (int tt = 0; tt < 4; ++tt) { const u32x2 iw = iwv[tt];
        o[tt][0] = acc[tt][0] + bflo(iw.x); o[tt][1] = acc[tt][1] + bfhi(iw.x); o[tt][2] = acc[tt][2] + bflo(iw.y); o[tt][3] = acc[tt][3] + bfhi(iw.y);
        float ss = o[tt][0] * o[tt][0] + o[tt][1] * o[tt][1] + o[tt][2] * o[tt][2] + o[tt][3] * o[tt][3];
        ss = rsum_fq(ss);
        if (fq == 0) red[(tt * 16 + fr) * 8 + w] = ss; }
    __syncthreads();
    const float* ng = (const float*)inp(a, 13) + l * 128; const f32x4 gn = *(const f32x4*)(ng + w * 16 + fq * 4);
    bf16_t* yb = (bf16_t*)(wsp(a) + WS_YB);
#pragma unroll
    for (int tt = 0; tt < 4; ++tt) { const LAS float* rp = red + (tt * 16 + fr) * 8; const f32x4 r0 = *(const LAS f32x4*)rp, r1 = *(const LAS f32x4*)(rp + 4);
        const float tot = ((r0[0] + r0[1]) + (r0[2] + r0[3])) + ((r1[0] + r1[1]) + (r1[2] + r1[3])); const float rs = rsqrtf(tot * (1.f / 128.f) + 1e-6f);
        const u32x2 gw = gwv[tt];
        const float g0 = bflo(gw.x), g1 = bfhi(gw.x), g2 = bflo(gw.y), g3 = bfhi(gw.y);
        u32x2 wv; wv.x = pk2(o[tt][0] * rs * gn[0] * g0 * sigm(g0), o[tt][1] * rs * gn[1] * g1 * sigm(g1)); wv.y = pk2(o[tt][2] * rs * gn[2] * g2 * sigm(g2), o[tt][3] * rs * gn[3] * g3 * sigm(g3));
        *(u32x2*)(yb + (size_t)(tok0 + tt * 16 + fr) * 512 + h * 128 + w * 16 + fq * 4) = wv; }
    __syncthreads();
}

__device__ __forceinline__ void cmp_gemm2(const Args& a, int l) {
    const int gtid = bidx() * 512 + tidx(), GT = gdim() * 512;
    const bf16_t* hid = (const bf16_t*)(wsp(a) + WS_HID); const float* w2 = (const float*)inp(a, 11) + (size_t)l * 2 * 256 * 64;
    bf16_t* kc = (bf16_t*)(wsp(a) + WS_KCMP); bf16_t* vc = (bf16_t*)(wsp(a) + WS_VCMPT);
    for (int idx = gtid; idx < 2048 * 64; idx += GT) { const int r = idx >> 6, d = idx & 63;
        const bf16_t* h0 = hid + (size_t)r * 256; const bf16_t* h1 = hid + (size_t)(2048 + r) * 256; const float* w0 = w2 + d; const float* w1 = w2 + 16384 + d; float s0 = 0.f, s1 = 0.f;
#pragma unroll 1
        for (int k0 = 0; k0 < 256; k0 += 32) { u32x4 ha[4], hb[4]; float wa[32], wb[32];
#pragma unroll
            for (int q = 0; q < 4; ++q) { ha[q] = *(const u32x4*)(h0 + k0 + q * 8); hb[q] = *(const u32x4*)(h1 + k0 + q * 8); }
#pragma unroll
            for (int j = 0; j < 32; ++j) { wa[j] = w0[(k0 + j) * 64]; wb[j] = w1[(k0 + j) * 64]; }
#pragma unroll
            for (int q = 0; q < 4; ++q) {
                s0 += bflo(ha[q].x) * wa[q * 8 + 0] + bfhi(ha[q].x) * wa[q * 8 + 1] + bflo(ha[q].y) * wa[q * 8 + 2] + bfhi(ha[q].y) * wa[q * 8 + 3] + bflo(ha[q].z) * wa[q * 8 + 4] + bfhi(ha[q].z) * wa[q * 8 + 5] + bflo(ha[q].w) * wa[q * 8 + 6] + bfhi(ha[q].w) * wa[q * 8 + 7];
                s1 += bflo(hb[q].x) * wb[q * 8 + 0] + bfhi(hb[q].x) * wb[q * 8 + 1] + bflo(hb[q].y) * wb[q * 8 + 2] + bfhi(hb[q].y) * wb[q * 8 + 3] + bflo(hb[q].z) * wb[q * 8 + 4] + bfhi(hb[q].z) * wb[q * 8 + 5] + bflo(hb[q].w) * wb[q * 8 + 6] + bfhi(hb[q].w) * wb[q * 8 + 7]; } }
        kc[(size_t)(r >> 7) * 8192 + kfrag_off(r & 127, d, 2)] = (bf16_t)(pk2(s0, 0.f) & 0xffffu);
        vc[(size_t)(r >> 7) * 8192 + vfrag_off(r & 127, d)] = (bf16_t)(pk2(s1, 0.f) & 0xffffu); }
}

struct MaskSel { unsigned mymask; int jb, tcol; __device__ __forceinline__ bool operator()(int, int key) const { return ((mymask >> jb) & 1u) && key <= tcol; } };
struct MaskWin { int tcol; __device__ __forceinline__ bool operator()(int, int key) const { return key <= tcol && key > tcol - 256; } };
struct MaskCausal2 { int t0, t1; __device__ __forceinline__ bool operator()(int ct, int key) const { return key <= (ct ? t1 : t0); } };

__device__ __forceinline__ void nsa_item(const Args& a, int item, int lane) {
    const int fr = lane & 15, fq = lane >> 4;
    const int t4 = ((item & 511) + 128 * (item >> 11)) & 511, g = (item >> 9) & 1, b = item >> 10;
    const int t0 = t4 * 4, tq = fr >> 2, r = fr & 3, tcol = t0 + tq, tok = b * SEQ + tcol, head = g * 4 + r;
    const bf16_t* P = (const bf16_t*)(wsp(a) + WS_PROJ); const f32x2* ropeN = (const f32x2*)(wsp(a) + WS_ROPEN);
    const float cs = 0.125f * LOG2E;
    const bf16_t* qp = P + (size_t)tok * PLD + PC_Q + head * 64 + fq * 8;
    bf16x8 qg[1][2], qr[1][2]; qg[0][0] = ld8(qp); qg[0][1] = ld8(qp + 32); qr[0][1] = qg[0][1];
    { const u32x4 own = __builtin_bit_cast(u32x4, qg[0][0]); u32x4 par;
      par.x = (unsigned)__shfl_xor((int)own.x, 16); par.y = (unsigned)__shfl_xor((int)own.y, 16); par.z = (unsigned)__shfl_xor((int)own.z, 16); par.w = (unsigned)__shfl_xor((int)own.w, 16);
      u32x4 res = own;
      if (fq < 2) { const float sgn = (fq == 0) ? -1.f : 1.f; const unsigned ow[4] = {own.x, own.y, own.z, own.w}, pw[4] = {par.x, par.y, par.z, par.w}; unsigned rw[4];
#pragma unroll
          for (int j = 0; j < 4; ++j) { const f32x2 c0 = ropeN[tok * 8 + 2 * j], c1 = ropeN[tok * 8 + 2 * j + 1];
              rw[j] = pk2(bflo(ow[j]) * c0.x + sgn * bflo(pw[j]) * c0.y, bfhi(ow[j]) * c1.x + sgn * bfhi(pw[j]) * c1.y); }
          res = (u32x4){rw[0], rw[1], rw[2], rw[3]}; }
      qr[0][0] = __builtin_bit_cast(bf16x8, res); }
    const int gb = g * 8 + b;
    const bf16_t* kc = (const bf16_t*)(wsp(a) + WS_KCMP) + (size_t)gb * 8192; const bf16_t* vc = (const bf16_t*)(wsp(a) + WS_VCMPT) + (size_t)gb * 8192;
    const int nv = tcol >= 31 ? ((tcol - 31) >> 4) + 1 : 0;
    float sc[4][8]; float mx = -1.0e30f;
#pragma unroll
    for (int s4 = 0; s4 < 4; ++s4) {
#pragma unroll
        for (int u = 0; u < 2; ++u) { f32x4 s = (f32x4){0.f, 0.f, 0.f, 0.f};
#pragma unroll
            for (int dc = 0; dc < 2; ++dc) s = mfma16(ld8(kc + ((s4 * 2 + u) * 2 + dc) * 512 + lane * 8), qg[0][dc], s);
#pragma unroll
            for (int j = 0; j < 4; ++j) { const int n = s4 * 32 + fq * 8 + u * 4 + j; const float v = (n < nv) ? s[j] * cs : -1.0e30f; sc[s4][u * 4 + j] = v; mx = fmaxf(mx, v); } } }
    mx = rmax_fq(mx);
    float lsum = 0.f;
#pragma unroll
    for (int s4 = 0; s4 < 4; ++s4)
#pragma unroll
        for (int e = 0; e < 8; ++e) { const int n = s4 * 32 + fq * 8 + e; const float p = (n < nv) ? ex2(sc[s4][e] - mx) : 0.f; sc[s4][e] = p; lsum += p; }
    lsum = rsum_fq(lsum);
    const float linv = lsum > 0.f ? 1.f / lsum : 0.f;
    f32x4 ocmp[4];
#pragma unroll
    for (int dt = 0; dt < 4; ++dt) ocmp[dt] = (f32x4){0.f, 0.f, 0.f, 0.f};
#pragma unroll
    for (int s4 = 0; s4 < 4; ++s4) {
#pragma unroll
        for (int e = 0; e < 8; ++e) sc[s4][e] *= linv;
        u32x4 pw; pw.x = pk2(sc[s4][0], sc[s4][1]); pw.y = pk2(sc[s4][2], sc[s4][3]); pw.z = pk2(sc[s4][4], sc[s4][5]); pw.w = pk2(sc[s4][6], sc[s4][7]);
        const bf16x8 pb = __builtin_bit_cast(bf16x8, pw);
#pragma unroll
        for (int dt = 0; dt < 4; ++dt) ocmp[dt] = mfma16(ld8(vc + (s4 * 4 + dt) * 512 + lane * 8), pb, ocmp[dt]);
#pragma unroll
        for (int e = 0; e < 8; ++e) sc[s4][e] = rsum_quad(sc[s4][e]);
    }
    float val[8];
    const int cur = tcol >> 6;
#pragma unroll
    for (int s4 = 0; s4 < 4; ++s4) { const float prev = __shfl(sc[s4][7], (lane - 16) & 63); const float prevm1 = (s4 > 0) ? __shfl(sc[s4 > 0 ? s4 - 1 : 0][7], (lane - 16) & 63) : 0.f;
        const float pm1 = (fq > 0) ? prev : prevm1;
#pragma unroll
        for (int h2 = 0; h2 < 2; ++h2) { const float m1 = h2 ? sc[s4][3] : pm1;
            const float imp = 0.5f * m1 + sc[s4][4 * h2] + sc[s4][4 * h2 + 1] + sc[s4][4 * h2 + 2] + 0.5f * sc[s4][4 * h2 + 3];
            const int jb = 8 * s4 + 2 * fq + h2; const bool vld = (jb * 64 <= tcol), forced = (jb == 0) || (jb == cur) || (jb == cur - 1);
            val[s4 * 2 + h2] = vld ? (forced ? 1.0e9f : imp) : -1.0e9f; } }
    int rank[8];
#pragma unroll
    for (int k = 0; k < 8; ++k) rank[k] = 0;
#pragma unroll
    for (int dq = 0; dq < 4; ++dq) {
#pragma unroll
        for (int k2 = 0; k2 < 8; ++k2) { const float ov = __shfl(val[k2], fr | (dq << 4)); const int ojb = 8 * (k2 >> 1) + 2 * dq + (k2 & 1);
#pragma unroll
            for (int k = 0; k < 8; ++k) { const int jb = 8 * (k >> 1) + 2 * fq + (k & 1); rank[k] += (ov > val[k] || (ov == val[k] && ojb < jb)) ? 1 : 0; } } }
    unsigned mymask = 0u;
#pragma unroll
    for (int k = 0; k < 8; ++k) { const int jb = 8 * (k >> 1) + 2 * fq + (k & 1); if (val[k] > -0.5e9f && rank[k] < 8) mymask |= (1u << jb); }
    mymask |= (unsigned)__shfl_xor((int)mymask, 16); mymask |= (unsigned)__shfl_xor((int)mymask, 32);
    unsigned U = (unsigned)__builtin_amdgcn_readlane((int)mymask, 0) | (unsigned)__builtin_amdgcn_readlane((int)mymask, 4) | (unsigned)__builtin_amdgcn_readlane((int)mymask, 8) | (unsigned)__builtin_amdgcn_readlane((int)mymask, 12);
    const bf16_t* vtn = (const bf16_t*)(wsp(a) + WS_VTN);
    FAS ss[1]; fas_init(ss[0]);
    const bf16_t* kfn = (const bf16_t*)(wsp(a) + WS_KFN);
    { const bf16_t* ksb = kfn + (size_t)((0 * 8 + b) * 2 + g) * 131072; const bf16_t* const kb[2] = {ksb, ksb + 512}; const int kcs[2] = {1024, 1024};
      const bf16_t* vt = vtn + (size_t)((0 * 2 + g) * 8 + b) * 131072;
      if (U) {
          int jb = __builtin_ctz(U); U &= U - 1u; FAFrag<2> f0, f1; fa_load<2>(f0, kb, kcs, vt, jb * 64, lane);
          for (;;) { fa_load<2>(f1, kb, kcs, vt, jb * 64 + 32, lane);
              { const MaskSel mk{mymask, jb, tcol}; fa_compute<1, 2>(ss, qr, f0, jb * 64, cs, true, mk, fr, fq); }
              const bool more = (U != 0u); int nj = jb;
              if (more) { nj = __builtin_ctz(U); U &= U - 1u; fa_load<2>(f0, kb, kcs, vt, nj * 64, lane); }
              { const MaskSel mk{mymask, jb, tcol}; fa_compute<1, 2>(ss, qr, f1, jb * 64 + 32, cs, true, mk, fr, fq); }
              if (!more) break; jb = nj; } } }
    FAS sw[1]; fas_init(sw[0]);
    { const bf16_t* kwb = kfn + (size_t)((1 * 8 + b) * 2 + g) * 131072; const bf16_t* const kb[2] = {kwb, kwb + 512}; const int kcs[2] = {1024, 1024};
      const bf16_t* vt = vtn + (size_t)((1 * 2 + g) * 8 + b) * 131072; const MaskWin mk{tcol};
      int k0 = t0 - 255; if (k0 < 0) k0 = 0; k0 &= ~31;
      for (; k0 + 32 <= t0 + 3; k0 += 64) fa_step2<1, 2>(sw, qr, kb, kcs, vt, k0, cs, true, true, mk, lane);
      if (k0 <= t0 + 3) fa_step<1, 2>(sw, qr, kb, kcs, vt, k0, cs, true, mk, lane); }
    const bf16_t* gp = P + (size_t)tok * PLD + PC_GATE + head * 3;
    const float g0 = sigm(bf2f(gp[0])), g1 = sigm(bf2f(gp[1])) * (ss[0].l > 0.f ? 1.f / ss[0].l : 0.f), g2 = sigm(bf2f(gp[2])) * (sw[0].l > 0.f ? 1.f / sw[0].l : 0.f);
    bf16_t* ya = (bf16_t*)(wsp(a) + WS_YA) + (size_t)tok * 512 + head * 64;
#pragma unroll
    for (int dt = 0; dt < 4; ++dt) { float o[4];
#pragma unroll
        for (int j = 0; j < 4; ++j) { o[j] = 0.f;
#ifdef MK_NB
            if (MK_NB & 1) o[j] += g0 * ocmp[dt][j]; if (MK_NB & 2) o[j] += g1 * ss[0].o[dt][j]; if (MK_NB & 4) o[j] += g2 * sw[0].o[dt][j];
#else
            o[j] = g0 * ocmp[dt][j] + g1 * ss[0].o[dt][j] + g2 * sw[0].o[dt][j];
#endif
        }
#ifdef MK_SAN
#pragma unroll
        for (int j = 0; j < 4; ++j) if (!(fabsf(o[j]) < 1.0e6f)) o[j] = 0.f;
#endif
        u32x2 w; w.x = pk2(o[0], o[1]); w.y = pk2(o[2], o[3]); *(u32x2*)(ya + dt * 16 + fq * 4) = w; }
}

__device__ __forceinline__ void mla_item(const Args& a, int item, int wave, int lane) {
    const int fr = lane & 15, fq = lane >> 4; const int bh = item & 63, qb = item >> 6, b = bh >> 3, h = bh & 7;
    const int q0 = qb * 256 + wave * 32;
    const bf16_t* mq = (const bf16_t*)(wsp(a) + WS_MQ); const bf16_t* kn = (const bf16_t*)(wsp(a) + WS_KNOPE); const bf16_t* kpe = (const bf16_t*)(wsp(a) + WS_KPE); const bf16_t* vtm = (const bf16_t*)(wsp(a) + WS_VTM);
    bf16x8 qf[2][3];
#pragma unroll
    for (int ct = 0; ct < 2; ++ct)
#pragma unroll
        for (int dc = 0; dc < 3; ++dc) qf[ct][dc] = ld8(mq + (size_t)(b * SEQ + q0 + ct * 16 + fr) * 768 + h * 96 + dc * 32 + fq * 8);
    const bf16_t* knb = kn + (size_t)(h * 8 + b) * 131072; const bf16_t* const kb[3] = {knb, knb + 512, kpe + (size_t)b * 65536}; const int kcs[3] = {1024, 1024, 512};
    const bf16_t* vt = vtm + (size_t)(h * 8 + b) * 131072;
    FAS st[2]; fas_init(st[0]); fas_init(st[1]);
    const MaskCausal2 mk{q0 + fr, q0 + 16 + fr};
    { int k0 = 0;
      for (; k0 + 32 <= q0; k0 += 64) fa_step2<2, 3>(st, qf, kb, kcs, vt, k0, 1.0f, false, k0 + 63 > q0, mk, lane);
      if (k0 <= q0) fa_step<2, 3>(st, qf, kb, kcs, vt, k0, 1.0f, k0 + 31 > q0, mk, lane); }
    bf16_t* yc = (bf16_t*)(wsp(a) + WS_YC);
#pragma unroll
    for (int ct = 0; ct < 2; ++ct) { const float inv = st[ct].l > 0.f ? 1.f / st[ct].l : 0.f; bf16_t* yp = yc + (size_t)(b * SEQ + q0 + ct * 16 + fr) * 512 + h * 64;
#pragma unroll
        for (int dt = 0; dt < 4; ++dt) { u32x2 w; w.x = pk2(st[ct].o[dt][0] * inv, st[ct].o[dt][1] * inv); w.y = pk2(st[ct].o[dt][2] * inv, st[ct].o[dt][3] * inv); *(u32x2*)(yp + dt * 16 + fq * 4) = w; } }
}

__device__ __forceinline__ void cmp_bias(const Args& a, int l) {
    const int lane = tidx() & 63, gw = bidx() * 8 + (tidx() >> 6); if (gw >= 512) return;
    const int which = gw >> 8, n = gw & 255; const bf16_t* w = (const bf16_t*)(wsp(a) + WS_W) + W_CMP + (size_t)(which * 256 + n) * 2048;
    const float* pe = (const float*)inp(a, 9) + (size_t)(l * 2 + which) * 2048; float s = 0.f;
#pragma unroll
    for (int i = 0; i < 4; ++i) { const int k = i * 512 + lane * 8; const u32x4 ww = *(const u32x4*)(w + k); const f32x4 p0 = *(const f32x4*)(pe + k), p1 = *(const f32x4*)(pe + k + 4);
        s += bflo(ww.x) * p0[0] + bfhi(ww.x) * p0[1] + bflo(ww.y) * p0[2] + bfhi(ww.y) * p0[3] + bflo(ww.z) * p1[0] + bfhi(ww.z) * p1[1] + bflo(ww.w) * p1[2] + bfhi(ww.w) * p1[3]; }
    s = wave_sum(s); if (lane == 0) ((float*)(wsp(a) + WS_CBIAS))[gw] = s;
}

__device__ __forceinline__ bool store_job(const Args& a, int kind, int j, g8::Desc& d, g8::EpiStore& e) {
    unsigned char* ws = wsp(a); const bf16_t* W = (const bf16_t*)(ws + WS_W); bf16_t* xb = (bf16_t*)(ws + WS_XB); bf16_t* P = (bf16_t*)(ws + WS_PROJ);
    d.aBS1 = d.aBS2 = d.bBS1 = d.bBS2 = 0; d.nB = 1; d.nB2 = 1; d.boff = 0;
    e.oBS1 = e.oBS2 = 0; e.split_shift = 0; e.split_stride = 0; e.rowscale = nullptr; e.colscale = nullptr; e.bias = nullptr; e.act = 0; e.nB2 = 1; e.lay = 0;
    if (kind == 1) {
        if (j == 0) { d.A = (const bf16_t*)(ws + WS_MEMB); d.Bt = W + W_XK; d.lda = d.ldb = d.K = 1024; d.nM = 8; d.nN = 4; d.boff = 128; e.O = (bf16_t*)(ws + WS_XAK); e.ldc = 1024; return true; }
        if (j == 1) { d.A = W + W_XV; d.Bt = (const bf16_t*)(ws + WS_MEMB); d.lda = d.ldb = d.K = 1024; d.nM = 4; d.nN = 1; d.nB = 8; d.bBS1 = 256 * 1024; d.boff = 160; e.O = (bf16_t*)(ws + WS_XAVT); e.oBS1 = 1024 * 256; e.ldc = 256; return true; }
        return false;
    }
    if (kind == 4) {
        if (j == 0) { d.A = xb; d.Bt = W + W_IN; d.lda = d.ldb = d.K = 1024; d.nM = 64; d.nN = 26; e.O = P; e.ldc = PLD; return true; }
        if (j == 1) { d.A = xb; d.Bt = W + W_IN + 6656 * 1024; d.lda = d.ldb = d.K = 1024; d.nM = 64; d.nN = 1; d.boff = 128; e.O = (bf16_t*)(ws + WS_KCG); e.ldc = 64; e.split_shift = 6; e.split_stride = (long)T * 64; return true; }
        if (j == 2) { d.A = W + W_IN + 6912 * 1024; d.Bt = xb; d.lda = d.ldb = d.K = 1024; d.nM = 1; d.nN = 64; d.boff = 192; e.O = (bf16_t*)(ws + WS_VTN); e.ldc = T; e.lay = 1; return true; }
        return false;
    }
    if (kind == 5) {
        if (j < 2) { d.A = (const bf16_t*)(ws + WS_KCG) + (size_t)j * 2 * T * 64; d.Bt = W + W_CMP + j * 256 * 2048; d.lda = 1024; d.ldb = 2048; d.K = 2048; d.nM = 8; d.nN = 1; d.boff = j * 8;
            e.O = (bf16_t*)(ws + WS_HID) + (size_t)j * 2048 * 256; e.ldc = 256; e.bias = (const float*)(ws + WS_CBIAS) + j * 256; e.act = 1; return true; }
        return false;
    }
    if (kind == 6) {
        if (j == 0) { d.A = P + PC_CKV; d.Bt = W + W_KN; d.lda = PLD; d.ldb = 256; d.K = 256; d.nM = 64; d.nN = 2; d.boff = 192; e.O = (bf16_t*)(ws + WS_KNOPE); e.ldc = 512; e.rowscale = (const float*)(ws + WS_RSKV); e.lay = 2; return true; }
        if (j == 1) { d.A = W + W_VM; d.Bt = P + PC_CKV; d.lda = 256; d.ldb = PLD; d.K = 256; d.nM = 2; d.nN = 64; d.boff = 64; e.O = (bf16_t*)(ws + WS_VTM); e.ldc = T; e.colscale = (const float*)(ws + WS_RSKV); e.lay = 1; return true; }
        return false;
    }
    if (kind == 11) {
        if (j == 0) { d.A = xb; d.Bt = W + W_XQ; d.lda = d.ldb = d.K = 1024; d.nM = 64; d.nN = 4; e.O = (bf16_t*)(ws + WS_XQ); e.ldc = 1024; return true; }
        return false;
    }
    if (kind == 13) {
        if (j == 0) { d.A = (const bf16_t*)(ws + WS_XP); d.lda = 1024; d.Bt = (const bf16_t*)(ws + WS_XAVT); d.ldb = 256; d.K = 256; d.nM = 64; d.nN = 4;
            e.O = (bf16_t*)(ws + WS_XO); e.ldc = 1024; return true; }
        return false;
    }
    return false;
}

constexpr int NPL = 13, NPH = 1 + NLAYER * NPL;
__global__ void __launch_bounds__(512, 2) mk_fwd(Args a) {
    extern __shared__ __attribute__((aligned(16))) unsigned char lds_raw[];
    LAS unsigned char* lds = (LAS unsigned char*)lds_raw;
    volatile LAS unsigned* bst = (volatile LAS unsigned*)(lds + LDS_BYTES - 64);
    if (threadIdx.x == 0) { bst[0] = 0u; bst[1] = 0u; }
    __syncthreads();
#pragma unroll 1
    for (int ph = a.ph_lo; ph < a.ph_hi; ++ph) {
        unsigned char* ws = wsp(a);
        const int tid = tidx(), lane = tid & 63, wave = __builtin_amdgcn_readfirstlane(tid >> 6), G = gdim();
        const bf16_t* W = (const bf16_t*)(ws + WS_W); bf16_t* xb = (bf16_t*)(ws + WS_XB); bf16_t* P = (bf16_t*)(ws + WS_PROJ);
        if (ph == 0) {
#ifndef NO_INIT
            phase_init(a);
#endif
        }
        else {
            const int l = (ph - 1) / NPL, k = (ph - 1) % NPL;
            int kind;
            switch (k) { case 0: kind = 0; break; case 1: case 11: kind = 1; break; case 2: case 8: case 10: case 12: kind = 2; break; case 3: kind = 4; break; case 4: kind = 5; break; case 5: kind = 6; break;
                         case 6: kind = 7; break; case 7: kind = 8; break; default: kind = 11; break; }
#ifndef NO_CONV
            if (kind == 0) phase_conv(a, l, lds);
#endif
#ifndef NO_UP
            if (kind == 1) { g8::Desc d; d.A = xb; d.Bt = W + (k == 1 ? W_UP1 : W_UP2); d.aBS1 = d.aBS2 = d.bBS1 = d.bBS2 = 0; d.lda = d.ldb = d.K = 1024; d.nM = 64; d.nN = 22; d.nB = 1; d.nB2 = 1; d.boff = 0;
                g8::EpiSwiglu e{(bf16_t*)(ws + WS_H)}; g8::desc_defaults(d); g8::gemm_phase(lds, d, e); if (k == 1) cmp_bias(a, l); }
#endif
#ifndef NO_RESID
            if (kind == 2) { g8::Desc d; d.aBS1 = d.aBS2 = d.bBS1 = d.bBS2 = 0; d.nM = 64; d.nN = 4; d.nB = 1; d.nB2 = 1; d.boff = 0; float s = 1.f; int j = 0;
                if (k == 2 || k == 12) { d.A = (const bf16_t*)(ws + WS_H); d.Bt = W + (k == 2 ? W_DN1 : W_DN2); d.lda = d.ldb = d.K = DFF; s = 0.5f; j = (k == 2) ? 0 : 3; }
                else if (k == 8) { d.A = xb; d.Bt = W + W_OUT; d.lda = d.ldb = d.K = 1024; j = 1; }
                else { d.A = (const bf16_t*)(ws + WS_XO); d.Bt = W + W_XO; d.lda = d.ldb = d.K = 1024; j = 2; }
                g8::EpiLn e{(l == 0 && j == 0) ? (const float*)inp(a, 0) : (const float*)outp(a), outp(a), xb, (const float*)inp(a, 3) + (size_t)(l * 4 + j) * DM, (const float*)inp(a, 4) + (size_t)(l * 4 + j) * DM, s,
                            (unsigned long long*)(ws + WS_XBUF), (unsigned*)(ws + WS_CNT), 16u * (unsigned)(l * 4 + j + 1)};
                g8::desc_defaults(d); g8::gemm_phase(lds, d, e); }
#endif
#ifndef NO_MLAQ
            if (kind == 6) { g8::Desc d; d.A = P + PC_CQ; d.Bt = W + W_UQ; d.aBS1 = d.aBS2 = d.bBS1 = d.bBS2 = 0; d.lda = PLD; d.ldb = 384; d.K = 384; d.nM = 64; d.nN = 3; d.nB = 1; d.nB2 = 1; d.boff = 0;
                g8::EpiMlaQ e{(bf16_t*)(ws + WS_MQ), (const float*)(ws + WS_RSQ), (const f32x2*)(ws + WS_ROPEM)}; g8::desc_defaults(d); g8::gemm_phase(lds, d, e); }
#endif
#ifndef NO_STORE
            if (kind == 1 || kind == 4 || kind == 5 || kind == 6 || kind == 11) {
                if (!(kind == 1 && k != 1)) {
#pragma unroll 1
                    for (int j = 0; j < 3; ++j) { g8::Desc d; g8::EpiStore e; if (!store_job(a, kind, j, d, e)) break; if (kind == 11 && j > 0) break; g8::desc_defaults(d); g8::gemm_phase(lds, d, e); } } }
#endif
            if (kind == 5) {
#ifndef NO_S1TOK
                s1_tokens(a);
#endif
#ifndef NO_H1
                {
                    unsigned* qctr = (unsigned*)(ws + WS_BAR) + 12288 + l * 64; volatile LAS int* qs = (volatile LAS int*)(lds + LDS_BYTES - 128);
                    for (;;) { if (tid == 0) *qs = (int)__hip_atomic_fetch_add(qctr, 1u, __ATOMIC_RELAXED, __HIP_MEMORY_SCOPE_AGENT);
                        __syncthreads(); const int it = *qs; __syncthreads(); if (it >= 1024) break; hgrn_stage1(a, l, it, lds); } }
#endif
            }
#ifndef NO_S2X
            if (kind == 6) { cmp_gemm2(a, l); hgrn_scan(a); }
#endif
            if (kind == 7) {
#ifndef NO_NSA
                { const int gw = bidx() * 8 + wave; for (int it = gw; it < 8192; it += G * 8) nsa_item(a, it, lane); }
#endif
#ifndef NO_MLA
                { const int bx = bidx(); if (bx < 256) { mla_item(a, bx, wave, lane); mla_item(a, 511 - bx, wave, lane); } }
#endif
#ifndef NO_H3
                { f32x4 hsv[8]; { const float* st0 = (const float*)(ws + WS_Z) + (size_t)bidx() * 16384;
#pragma unroll
                      for (int i = 0; i < 8; ++i) { const int ii = tid + i * 512; hsv[i] = *(const f32x4*)(st0 + (ii >> 5) * 128 + (ii & 31) * 4); } }
                  for (int it = bidx(); it < 1024; it += G) hgrn_stage3(a, l, it, it + G, hsv, lds); }
#endif
            }
#ifndef NO_MERGE
            if (kind == 8) {
                { g8::Desc d; d.A = (const bf16_t*)(ws + WS_YA); d.Bt = W + W_BR; d.aBS1 = (long)T * 512; d.bBS1 = 1024 * 512; d.aBS2 = d.bBS2 = 0; d.lda = d.ldb = d.K = 512; d.nM = 64; d.nN = 4; d.nB = 3; d.nB2 = 1; d.boff = 0;
                  g8::EpiMerge e{P, (float*)(ws + WS_Z), xb, 0}; g8::desc_defaults(d); d.bmode = 1; g8::gemm_phase(lds, d, e); } }
#endif
#ifndef NO_XAS
            if (kind == 11) {
                { g8::Desc d; d.A = (const bf16_t*)(ws + WS_XQ); d.Bt = (const bf16_t*)(ws + WS_XAK); d.aBS1 = d.aBS2 = d.bBS1 = d.bBS2 = 0; d.lda = 1024; d.ldb = 1024; d.K = 256; d.nM = 64; d.nN = 4; d.nB = 1; d.nB2 = 1; d.boff = 0;
                  d.aN = 256; d.bN = 256; d.bB = 256 * 1024; d.bmode = 0;
                  g8::EpiXaSoft e{(bf16_t*)(ws + WS_XP), 0, 0, 1024, 1, 0.0625f * LOG2E}; g8::gemm_phase(lds, d, e); }
                { g8::Desc d; g8::EpiStore e; (void)store_job(a, 13, 0, d, e); d.aN = 256; d.bN = 256 * 256; d.bB = 1024 * 256; d.bmode = 0; g8::gemm_phase(lds, d, e); } }
#endif
        }
        if (ph + 1 < a.ph_hi) {
            if (ph == 0) {
                cg::this_grid().sync();
                if (threadIdx.x == 0) (void)xb_add(&((unsigned*)(wsp(a) + WS_BAR))[XB_XCNT(xb_xcc_id())], 1u);
            } else xcd_barrier((unsigned*)(wsp(a) + WS_BAR), bst);
        }
    }
}

#ifndef MK_PH_HI
#define MK_PH_HI NPH
#endif
#ifndef MK_ONE_LAUNCH
#define MK_ONE_LAUNCH 1
#endif
extern "C" void kernel_launch(void* const* d_in, const int* in_sizes, int n_in, void* d_out, int out_size, void* d_ws, size_t ws_size, hipStream_t stream) {
    static int grid = 0;
    if (grid == 0) {
        if (n_in != 24 || out_size != T * DM || ws_size < WS_END) { fprintf(stderr, "kernel_launch: unexpected problem (n_in %d out %d ws %zu need %zu)\n", n_in, out_size, ws_size, (size_t)WS_END); grid = -1; return; }
        int dev = 0, cus = 0;
        if (hipGetDevice(&dev) != hipSuccess || hipDeviceGetAttribute(&cus, hipDeviceAttributeMultiprocessorCount, dev) != hipSuccess) { grid = -1; return; }
        if (hipFuncSetAttribute((const void*)mk_fwd, hipFuncAttributeMaxDynamicSharedMemorySize, LDS_BYTES) != hipSuccess) { fprintf(stderr, "kernel_launch: hipFuncSetAttribute failed\n"); grid = -1; return; }
        (void)hipGetLastError();
        grid = cus;
        if (grid != 256) fprintf(stderr, "kernel_launch: %d CUs (built for 256)\n", grid);
    }
    if (grid < 0) return;
    Args a{};
    for (int i = 0; i < 24; ++i) a.in[i] = d_in[i];
    a.out = (float*)d_out; a.ws = (unsigned char*)d_ws;
#if MK_ONE_LAUNCH
    a.ph_lo = 0; a.ph_hi = MK_PH_HI;
    void* args[] = {&a};
    hipError_t e = hipLaunchCooperativeKernel((const void*)mk_fwd, dim3(grid), dim3(512), args, LDS_BYTES, stream);
    if (e != hipSuccess) fprintf(stderr, "kernel_launch: cooperative launch failed: %s\n", hipGetErrorString(e));
#else
    for (int ph = 0; ph < NPH; ++ph) { a.ph_lo = ph; a.ph_hi = ph + 1; hipLaunchKernelGGL(mk_fwd, dim3(grid), dim3(512), LDS_BYTES, stream, a); }
#endif
}
```
